# Optimizing an MI355X kernel written in HIP

```python
import math
import jax, jax.numpy as jnp
from jax import lax
import numpy as np

D_MODEL = 2048
BATCH = 4
SEQ = 4096
DEPTH = 2

GRID_W = 64
CTX_LEN = 256
N_MIXERS = 2
N_RWKV_LAYERS = (DEPTH + N_MIXERS - 1) // N_MIXERS
N_MLA_LAYERS = DEPTH // N_MIXERS
RMS_EPS = 1e-6
RWKV_HEAD = 64
RWKV_HEADS = D_MODEL // RWKV_HEAD
DECAY_LORA = 96
ICLR_LORA = 96
GATE_LORA = 256
GN_EPS = 64e-5
MLA_HEADS = 16
Q_LORA = 512
KV_LORA = 512
QK_NOPE = 128
QK_ROPE = 64
V_HEAD = 128
MLA_SCALE = (QK_NOPE + QK_ROPE) ** -0.5
ROPE_THETA = 10000.0
ROPE_PAIRS_PER_AXIS = QK_ROPE // 4
Q_BLOCK = 128
D_FF = 5632
CONV_W = 3

kernel_name = "hybrid_rwkv7_mla_convffn_dit"


def rmsnorm(x, g):
    xf = x.astype(jnp.float32)
    y = xf * lax.rsqrt(jnp.mean(xf * xf, axis=-1, keepdims=True) + RMS_EPS)
    return y.astype(x.dtype) * g


def modulate(h, shift, scale):
    return h * (1.0 + scale) + shift


def shift_prev_next(h):
    z = jnp.zeros_like(h[:, :1])
    prev = jnp.concatenate([z, h[:, :-1]], axis=1)
    nxt = jnp.concatenate([h[:, 1:], z], axis=1)
    return prev, nxt


def l2_normalize(t):
    tf = t.astype(jnp.float32)
    n = jnp.sqrt(jnp.sum(tf * tf, axis=-1, keepdims=True))
    return (tf / jnp.maximum(n, 1e-12)).astype(t.dtype)


def rwkv_project(h, mu, wr, wk, wv, w0, w1, w2, a0, a1, a2, g1, g2, k_k, k_a):
    B, L, _ = h.shape
    heads = lambda t: t.reshape(B, L, RWKV_HEADS, RWKV_HEAD)
    prev, nxt = shift_prev_next(h)
    xx = 0.5 * (prev + nxt) - h
    xr, xw, xk, xv, xa, xg = (h + xx * mu[j] for j in range(6))
    r = heads(xr @ wr)
    k = xk @ wk
    v = heads(xv @ wv)
    g = jax.nn.sigmoid(xg @ g1) @ g2
    kk = l2_normalize(heads(k * k_k))
    dirs = []
    for d in range(2):
        w_log = -jax.nn.softplus(-(w0[d] + jnp.tanh(xw @ w1[d]) @ w2[d])) - 0.5
        decay = jnp.exp(-jnp.exp(w_log.astype(jnp.float32)))
        a = jax.nn.sigmoid(a0[d] + (xa @ a1[d]) @ a2[d])
        kd = heads(k * (1.0 + (a - 1.0) * k_a))
        dirs.append((heads(decay), kd, kk * heads(a)))
    return r, v, g, kk, dirs


def rwkv7_scan(S0, r, w, k, v, a, b, reverse):
    xs = tuple(jnp.moveaxis(t.astype(jnp.float32), 1, 0) for t in (r, w, k, v, a, b))

    def step(S, inp):
        rt, wt, kt, vt, at, bt = inp
        sa = jnp.einsum('bhvk,bhk->bhv', S, at)
        S = S * wt[:, :, None, :] + sa[..., :, None] * bt[:, :, None, :] + vt[..., :, None] * kt[:, :, None, :]
        return S, jnp.einsum('bhvk,bhk->bhv', S, rt)

    S, ys = lax.scan(step, S0, xs, reverse=reverse)
    return S, jnp.moveaxis(ys, 0, 1)


def rwkv_readout(y, r, ks, v, g, r_k, gn_w, gn_b, wo):
    B, L, H, N = r.shape
    mean = jnp.mean(y, axis=-1, keepdims=True)
    var = jnp.mean((y - mean) ** 2, axis=-1, keepdims=True)
    yn = ((y - mean) * lax.rsqrt(var + GN_EPS)).astype(r.dtype).reshape(B, L, H * N) * gn_w + gn_b
    bonus = (jnp.sum(r * ks[0] * r_k, axis=-1, keepdims=True)
             + jnp.sum(r * ks[1] * r_k, axis=-1, keepdims=True)) * v
    return ((yn + bonus.reshape(B, L, H * N)) * g) @ wo


def rwkv_mixer(h_ctx, h_lat, need_ctx, mu, wr, wk, wv, wo, w0, w1, w2, a0, a1, a2, g1, g2,
               k_k, k_a, r_k, gn_w, gn_b):
    proj = lambda h: rwkv_project(h, mu, wr, wk, wv, w0, w1, w2, a0, a1, a2, g1, g2, k_k, k_a)
    rc, vc, gc, kkc, dc = proj(h_ctx)
    rl, vl, gl, kkl, dl = proj(h_lat)
    B = h_lat.shape[0]
    S0 = jnp.zeros((B, RWKV_HEADS, RWKV_HEAD, RWKV_HEAD), jnp.float32)
    ys_c, ys_l = [], []
    for d, rev in enumerate((False, True)):
        wc, kc, bc = dc[d]
        wl, kl, bl = dl[d]
        S_ctx, yc = rwkv7_scan(S0, rc, wc, kc, vc, -kkc, bc, rev)
        _, yl = rwkv7_scan(S_ctx, rl, wl, kl, vl, -kkl, bl, rev)
        ys_c.append(yc)
        ys_l.append(yl)
    out_l = rwkv_readout(ys_l[0] + ys_l[1], rl, (dl[0][1], dl[1][1]), vl, gl, r_k, gn_w, gn_b, wo)
    out_c = None
    if need_ctx:
        out_c = rwkv_readout(ys_c[0] + ys_c[1], rc, (dc[0][1], dc[1][1]), vc, gc, r_k, gn_w, gn_b, wo)
    return out_l, out_c


def rope_half(x, cos, sin):
    x1, x2 = jnp.split(x, 2, axis=-1)
    return jnp.concatenate([x1 * cos - x2 * sin, x2 * cos + x1 * sin], axis=-1)


def axial_rope(x, cos_r, sin_r, cos_c, sin_c):
    xr, xc = jnp.split(x, 2, axis=-1)
    return jnp.concatenate([rope_half(xr, cos_r, sin_r), rope_half(xc, cos_c, sin_c)], axis=-1)


def mla_project(h, wdown, qnorm, kvnorm, wuq, wukv, rope):
    B, L, _ = h.shape
    c_q, c_kv, k_rope = jnp.split(h @ wdown, [Q_LORA, Q_LORA + KV_LORA], axis=-1)
    q = (rmsnorm(c_q, qnorm) @ wuq).reshape(B, L, MLA_HEADS, QK_NOPE + QK_ROPE)
    kv = (rmsnorm(c_kv, kvnorm) @ wukv).reshape(B, L, MLA_HEADS, QK_NOPE + V_HEAD)
    q_nope, q_rope = jnp.split(q, [QK_NOPE], axis=-1)
    k_nope, v = jnp.split(kv, [QK_NOPE], axis=-1)
    if rope is not None:
        q_rope = axial_rope(q_rope, *(t[:, None, :] for t in rope))
        k_rope = axial_rope(k_rope, *rope)
    return q_nope, q_rope, k_nope, k_rope, v


def mla_attend(q_nope, q_rope, k_nope, k_rope, v):
    s = (jnp.einsum('bqhd,bkhd->bhqk', q_nope, k_nope)
         + jnp.einsum('bqhr,bkr->bhqk', q_rope, k_rope))
    p = jax.nn.softmax(s.astype(jnp.float32) * MLA_SCALE, axis=-1).astype(v.dtype)
    return jnp.einsum('bhqk,bkhd->bqhd', p, v)


def mla_mixer(h_ctx, h_lat, need_ctx, rope, wdown, qnorm, kvnorm, wuq, wukv, wo):
    qn_c, qr_c, kn_c, kr_c, v_c = mla_project(h_ctx, wdown, qnorm, kvnorm, wuq, wukv, None)
    qn_l, qr_l, kn_l, kr_l, v_l = mla_project(h_lat, wdown, qnorm, kvnorm, wuq, wukv, rope)
    kn = jnp.concatenate([kn_c, kn_l], axis=1)
    kr = jnp.concatenate([kr_c, kr_l], axis=1)
    v = jnp.concatenate([v_c, v_l], axis=1)
    B, L = h_lat.shape[0], h_lat.shape[1]
    nb = L // Q_BLOCK
    to_blocks = lambda t: jnp.moveaxis(t.reshape(B, nb, Q_BLOCK, *t.shape[2:]), 1, 0)
    o = lax.map(lambda qb: mla_attend(qb[0], qb[1], kn, kr, v), (to_blocks(qn_l), to_blocks(qr_l)))
    o = jnp.moveaxis(o, 0, 1).reshape(B, L, MLA_HEADS * V_HEAD)
    out_l = o @ wo
    out_c = None
    if need_ctx:
        oc = mla_attend(qn_c, qr_c, kn_c, kr_c, v_c)
        out_c = oc.reshape(B, h_ctx.shape[1], MLA_HEADS * V_HEAD) @ wo
    return out_l, out_c


def conv_ffn(h, wup, conv_w, conv_b, wdown):
    gate, val = jnp.split(h @ wup, 2, axis=-1)
    prev, nxt = shift_prev_next(gate)
    gate = prev * conv_w[0] + gate * conv_w[1] + nxt * conv_w[2] + conv_b
    return (jax.nn.silu(gate) * val) @ wdown


def setup_inputs(seed: int = 0) -> dict:
    key = jax.random.key(seed)
    ks = iter(jax.random.split(key, 48))
    f32 = jnp.float32
    D, H, N, NA, NB = D_MODEL, RWKV_HEADS, RWKV_HEAD, N_RWKV_LAYERS, N_MLA_LAYERS

    def nrm(shape, scale):
        return jax.random.normal(next(ks), shape, f32) * scale

    def gain(shape):
        return 1.0 + nrm(shape, 0.02)

    decay_base = -6.0 + 5.0 * jnp.linspace(0.0, 1.0, D, dtype=f32) ** 1.5
    return {
        "x": nrm((BATCH, SEQ, D), 1.0),
        "c": nrm((BATCH, D), 1.0),
        "ctx": nrm((BATCH, CTX_LEN, D), 1.0),
        "c_ctx": nrm((D,), 1.0),
        "ada_w": nrm((DEPTH, D, 6 * D), 0.5 * D ** -0.5),
        "ada_b": nrm((DEPTH, 6 * D), 0.02),
        "norm_g": gain((DEPTH, 2, D)),
        "final_g": gain((D,)),
        "rk_mu": jax.random.uniform(next(ks), (NA, 6, D), f32),
        "rk_wr": nrm((NA, D, D), D ** -0.5),
        "rk_wk": nrm((NA, D, D), D ** -0.5),
        "rk_wv": nrm((NA, D, D), D ** -0.5),
        "rk_wo": nrm((NA, D, D), D ** -0.5),
        "rk_w0": decay_base + nrm((NA, 2, D), 0.1),
        "rk_w1": nrm((NA, 2, D, DECAY_LORA), D ** -0.5),
        "rk_w2": nrm((NA, 2, DECAY_LORA, D), 0.1 * DECAY_LORA ** -0.5),
        "rk_a0": nrm((NA, 2, D), 0.1),
        "rk_a1": nrm((NA, 2, D, ICLR_LORA), D ** -0.5),
        "rk_a2": nrm((NA, 2, ICLR_LORA, D), 0.1 * ICLR_LORA ** -0.5),
        "rk_g1": nrm((NA, D, GATE_LORA), D ** -0.5),
        "rk_g2": nrm((NA, GATE_LORA, D), GATE_LORA ** -0.5),
        "rk_kk": 0.85 + nrm((NA, D), 0.02),
        "rk_ka": gain((NA, D)),
        "rk_rk": nrm((NA, H, N), 0.1),
        "rk_gn_w": gain((NA, D)),
        "rk_gn_b": nrm((NA, D), 0.02),
        "ml_wdown": nrm((NB, D, Q_LORA + KV_LORA + QK_ROPE), D ** -0.5),
        "ml_qnorm": gain((NB, Q_LORA)),
        "ml_kvnorm": gain((NB, KV_LORA)),
        "ml_wuq": nrm((NB, Q_LORA, MLA_HEADS * (QK_NOPE + QK_ROPE)), Q_LORA ** -0.5),
        "ml_wukv": nrm((NB, KV_LORA, MLA_HEADS * (QK_NOPE + V_HEAD)), KV_LORA ** -0.5),
        "ml_wo": nrm((NB, MLA_HEADS * V_HEAD, D), (MLA_HEADS * V_HEAD) ** -0.5),
        "ff_wup": nrm((DEPTH, D, 2 * D_FF), D ** -0.5),
        "ff_conv": nrm((DEPTH, CONV_W, D_FF), 0.5),
        "ff_convb": nrm((DEPTH, D_FF), 0.02),
        "ff_wdown": nrm((DEPTH, D_FF, D), D_FF ** -0.5),
    }


def reference(x, c, ctx, c_ctx, ada_w, ada_b, norm_g, final_g,
              rk_mu, rk_wr, rk_wk, rk_wv, rk_wo, rk_w0, rk_w1, rk_w2, rk_a0, rk_a1, rk_a2,
              rk_g1, rk_g2, rk_kk, rk_ka, rk_rk, rk_gn_w, rk_gn_b,
              ml_wdown, ml_qnorm, ml_kvnorm, ml_wuq, ml_wukv, ml_wo,
              ff_wup, ff_conv, ff_convb, ff_wdown):
    n_lat = x.shape[1]
    rows = n_lat // GRID_W
    row = jnp.broadcast_to(jnp.arange(rows)[:, None], (rows, GRID_W)).reshape(-1)
    col = jnp.broadcast_to(jnp.arange(GRID_W)[None, :], (rows, GRID_W)).reshape(-1)
    inv_freq = jnp.float32(ROPE_THETA) ** (-jnp.arange(ROPE_PAIRS_PER_AXIS, dtype=jnp.float32) / ROPE_PAIRS_PER_AXIS)
    ang_r = row.astype(jnp.float32)[:, None] * inv_freq
    ang_c = col.astype(jnp.float32)[:, None] * inv_freq
    rope = (jnp.cos(ang_r).astype(x.dtype), jnp.sin(ang_r).astype(x.dtype),
            jnp.cos(ang_c).astype(x.dtype), jnp.sin(ang_c).astype(x.dtype))

    s_ctx = ctx
    for i in range(DEPTH):
        last = i == DEPTH - 1
        m_lat = jax.nn.silu(c) @ ada_w[i] + ada_b[i]
        m_ctx = jax.nn.silu(c_ctx) @ ada_w[i] + ada_b[i]
        sh1, sc1, gt1, sh2, sc2, gt2 = (t[:, None, :] for t in jnp.split(m_lat, 6, axis=-1))
        csh1, csc1, cgt1, csh2, csc2, cgt2 = jnp.split(m_ctx, 6, axis=-1)

        h_lat = modulate(rmsnorm(x, norm_g[i, 0]), sh1, sc1)
        h_ctx = modulate(rmsnorm(s_ctx, norm_g[i, 0]), csh1, csc1)
        j = i // N_MIXERS
        if i % N_MIXERS == 0:
            out_l, out_c = rwkv_mixer(h_ctx, h_lat, not last, rk_mu[j], rk_wr[j], rk_wk[j], rk_wv[j], rk_wo[j],
                                      rk_w0[j], rk_w1[j], rk_w2[j], rk_a0[j], rk_a1[j], rk_a2[j],
                                      rk_g1[j], rk_g2[j], rk_kk[j], rk_ka[j], rk_rk[j], rk_gn_w[j], rk_gn_b[j])
        else:
            out_l, out_c = mla_mixer(h_ctx, h_lat, not last, rope, ml_wdown[j], ml_qnorm[j], ml_kvnorm[j],
                                     ml_wuq[j], ml_wukv[j], ml_wo[j])
        x = x + gt1 * out_l
        hf_lat = modulate(rmsnorm(x, norm_g[i, 1]), sh2, sc2)
        x = x + gt2 * conv_ffn(hf_lat, ff_wup[i], ff_conv[i], ff_convb[i], ff_wdown[i])
        if not last:
            s_ctx = s_ctx + cgt1 * out_c
            hf_ctx = modulate(rmsnorm(s_ctx, norm_g[i, 1]), csh2, csc2)
            s_ctx = s_ctx + cgt2 * conv_ffn(hf_ctx, ff_wup[i], ff_conv[i], ff_convb[i], ff_wdown[i])
    return rmsnorm(x, final_g)
```

```cpp
#include <hip/hip_runtime.h>
#include <hip/hip_cooperative_groups.h>
#include <cstdio>
#include <cstdint>
namespace cg = cooperative_groups;

#define LAS __attribute__((address_space(3)))
typedef unsigned short bf16_t;
typedef short bf16x8 __attribute__((ext_vector_type(8)));
typedef short s16x4 __attribute__((ext_vector_type(4)));
typedef float f32x4 __attribute__((ext_vector_type(4)));
typedef float f32x2 __attribute__((ext_vector_type(2)));
typedef float f32x16 __attribute__((ext_vector_type(16)));
typedef unsigned u32x4 __attribute__((ext_vector_type(4)));
typedef unsigned u32x2 __attribute__((ext_vector_type(2)));

constexpr int D = 2048, NL = 16384, NC = 1024, T = NL + NC, SEQ = 4096, CTXL = 256, DFF = 5632, MODW = 12288;
constexpr size_t MiB = 1u << 20;
constexpr size_t WS_MOD = 0;
constexpr size_t WS_BAR = 512 * 1024;
constexpr size_t WS_XC = 1 * MiB;
constexpr size_t WS_W = 9 * MiB;
constexpr size_t WS_BIG = 115 * MiB;
constexpr size_t WS_KV = 523 * MiB;
constexpr size_t WS_GF = WS_BIG + 32 * MiB;
constexpr size_t WS_BON = 676 * MiB;
constexpr size_t WS_END = 681 * MiB;
constexpr size_t W_RKV = 0, W_RWO = 24 * MiB, W_L1 = 32 * MiB, W_L2 = 35 * MiB, W_G2 = 39 * MiB, W_UP = 40 * MiB, W_DN = 84 * MiB;
constexpr size_t W_MLD = 0, W_UQ = 5 * MiB, W_UKV = 8 * MiB, W_MLO = 12 * MiB;
constexpr size_t S68 = 68 * MiB;
constexpr int LDS_BYTES = 147456;

struct Params { const float* in[36]; float* out; unsigned char* ws; };
typedef const __attribute__((address_space(4))) unsigned char* kptr_t;
struct KP {
    kptr_t p;
    __device__ __forceinline__ const float* in(int i) const { return *(const float* const __attribute__((address_space(4)))*)(p + 8 * i); }
    __device__ __forceinline__ float* out() const { return *(float* const __attribute__((address_space(4)))*)(p + 288); }
    __device__ __forceinline__ unsigned char* ws() const { return *(unsigned char* const __attribute__((address_space(4)))*)(p + 296); }
};
__device__ __forceinline__ KP kargs() { kptr_t p = (kptr_t)__builtin_amdgcn_kernarg_segment_ptr(); asm volatile("" : "+s"(p)); KP k; k.p = p; return k; }

typedef __bf16 bf16x2_t __attribute__((ext_vector_type(2)));
__device__ __forceinline__ unsigned cvt_pk_bf16(float lo, float hi) { const f32x2 v = {lo, hi}; const bf16x2_t b = __builtin_convertvector(v, bf16x2_t); return __builtin_bit_cast(unsigned, b); }
__device__ __forceinline__ unsigned cvt_pk_f16(float lo, float hi) { _Float16 a = (_Float16)lo, b = (_Float16)hi; return (unsigned)__builtin_bit_cast(unsigned short, a) | ((unsigned)__builtin_bit_cast(unsigned short, b) << 16); }
__device__ __forceinline__ float bf_lo(unsigned w) { return __uint_as_float(w << 16); }
__device__ __forceinline__ float bf_hi(unsigned w) { return __uint_as_float(w & 0xffff0000u); }
__device__ __forceinline__ float h_lo(unsigned w) { return (float)__builtin_bit_cast(_Float16, (unsigned short)(w & 0xffffu)); }
__device__ __forceinline__ float h_hi(unsigned w) { return (float)__builtin_bit_cast(_Float16, (unsigned short)(w >> 16)); }
__device__ __forceinline__ float sigmoidf_(float x) { return __builtin_amdgcn_rcpf(1.0f + __expf(-x)); }
__device__ __forceinline__ float tanhf_(float x) { const float e = __expf(2.0f * x); return 1.0f - 2.0f * __builtin_amdgcn_rcpf(e + 1.0f); }
__device__ __forceinline__ float wave_sum(float v) {
#pragma unroll
    for (int o = 1; o < 64; o <<= 1) v += __shfl_xor(v, o);
    return v;
}
template <int CTRL> __device__ __forceinline__ float dpp_mov(float x) { return __int_as_float(__builtin_amdgcn_update_dpp(0, __float_as_int(x), CTRL, 0xF, 0xF, true)); }
__device__ __forceinline__ float red8(float x) { x += dpp_mov<0xB1>(x); x += dpp_mov<0x4E>(x); x += dpp_mov<0x141>(x); return x; }
__device__ __forceinline__ float red16(float x) { x += dpp_mov<0xB1>(x); x += dpp_mov<0x4E>(x); x += dpp_mov<0x141>(x); x += dpp_mov<0x140>(x); return x; }

namespace pg8 {
constexpr int BM = 256, BK = 64, HALF = 128, HTB = HALF * BK * 2, STAGE_BYTES = 8 * HTB, NXCD = 8, WGM = 8;
__device__ __forceinline__ int lds_byte(int r, int c) { const int st = (r >> 4) * 2 + (c >> 5), rr = r & 15, cc = c & 31, ob = rr * 64 + cc * 2; return st * 1024 + (ob ^ (((ob >> 9) & 1) << 5)); }
__device__ __forceinline__ void stage_rc(int b, int& R, int& C) { const int st = b / 1024, sb = b % 1024, swz = sb ^ (((sb >> 9) & 1) << 5); R = (st >> 1) * 16 + swz / 64; C = (st & 1) * 32 + (swz % 64) / 2; }
__device__ __forceinline__ int perm32(int rho) { const int n = rho >> 4, i = rho & 15; return 8 * (i >> 2) + 4 * n + (i & 3); }

struct Unit { int pm, pn, z; };
struct Gemm { const bf16_t* A; const bf16_t* Bt; int lda, ldb; int sAz, sBz; int M, N, K, nz; };
struct StaticOrder {
    int nM, nN, nwg, G, c, tot;
    __device__ void init(int M, int N, int nz, int G_, int c_) { nM = M / BM; nN = N / BM; nwg = nM * nN; G = G_; c = c_; tot = nwg * nz; }
    __device__ bool next(int i, Unit& u) const {
        const long L = (long)i * G + c; if (L >= tot) return false;
        u.z = (int)(L / nwg);
        int wgid = (int)(L % nwg); { const int q = nwg / NXCD, r = nwg % NXCD, xcd = wgid % NXCD, off = wgid / NXCD; wgid = (xcd < r ? xcd * (q + 1) : r * (q + 1) + (xcd - r) * q) + off; }
        const int nig = WGM * nN, gid = wgid / nig, fm = gid * WGM, gsz = (nM - fm) < WGM ? (nM - fm) : WGM;
        u.pm = fm + ((wgid % nig) % gsz); u.pn = (wgid % nig) / gsz; return true;
    }
};

struct Epi {
    int mode;
    int perm;
    int acts;
    int ldc; long sCz;
    union { void* o0; const float* xin_l; };
    union { void* o1; const float* xin_c; };
    union { void* o2; float* xout_l; };
    union { const float* b0; float* xout_c; };
    union { const float* b1; const float* gate; };
};
__device__ __forceinline__ void epilogue(const Epi& E, const f32x4 (&acc)[2][2][4][2], const Unit& u, int wr, int wc, int fr, int fq) {
    if (E.mode == 4) {
        bf16_t* Gf = (bf16_t*)E.o0; bf16_t* RAW = (bf16_t*)E.o1; bf16_t* VAL = (bf16_t*)E.o2;
        const int ch0 = u.pn * HALF + wc * 32 + 8 * fq;
        f32x4 cw0[2], cw1[2], cw2[2], cbb[2];
#pragma unroll
        for (int n = 0; n < 2; ++n) { cw0[n] = *(const f32x4*)(E.b0 + ch0 + 4 * n); cw1[n] = *(const f32x4*)(E.b0 + DFF + ch0 + 4 * n); cw2[n] = *(const f32x4*)(E.b0 + 2 * DFF + ch0 + 4 * n); cbb[n] = *(const f32x4*)(E.b1 + ch0 + 4 * n); }
#pragma unroll
        for (int ai = 0; ai < 2; ++ai) {
            const int rowb = u.pm * BM + ai * HALF + wr * 64, blk = rowb >> 6;
#pragma unroll
            for (int m = 0; m < 4; ++m) {
                float o[8];
#pragma unroll
                for (int n = 0; n < 2; ++n) {
                    const f32x4 c0 = cw0[n], c1 = cw1[n], c2 = cw2[n], cbv = cbb[n];
#pragma unroll
                    for (int e = 0; e < 4; ++e) {
                        const float gc = acc[ai][0][m][n][e];
                        const float gp = m > 0 ? acc[ai][0][m > 0 ? m - 1 : 0][n][e] : dpp_mov<0x121>(acc[ai][0][3][n][e]);
                        const float gn = m < 3 ? acc[ai][0][m < 3 ? m + 1 : 3][n][e] : dpp_mov<0x12F>(acc[ai][0][0][n][e]);
                        const float gt = gp * c0[e] + gc * c1[e] + gn * c2[e] + cbv[e];
                        o[4 * n + e] = gt * __builtin_amdgcn_rcpf(1.0f + __expf(-gt)) * acc[ai][1][m][n][e];
                    }
                }
                u32x4 w; w.x = cvt_pk_bf16(o[0], o[1]); w.y = cvt_pk_bf16(o[2], o[3]); w.z = cvt_pk_bf16(o[4], o[5]); w.w = cvt_pk_bf16(o[6], o[7]);
                *(u32x4*)(Gf + (size_t)(rowb + 4 * fr + m) * DFF + ch0) = w;
                {
                    const int br = 4 * fr + m;
                    const int slot = br == 0 ? 0 : br == 1 ? 1 : br == 62 ? 2 : br == 63 ? 3 : -1;
                    if (slot >= 0) {
                        u32x4 g; g.x = cvt_pk_bf16(acc[ai][0][m][0][0], acc[ai][0][m][0][1]); g.y = cvt_pk_bf16(acc[ai][0][m][0][2], acc[ai][0][m][0][3]);
                        g.z = cvt_pk_bf16(acc[ai][0][m][1][0], acc[ai][0][m][1][1]); g.w = cvt_pk_bf16(acc[ai][0][m][1][2], acc[ai][0][m][1][3]);
                        *(u32x4*)(RAW + ((size_t)blk * 4 + slot) * DFF + ch0) = g;
                        if (slot == 0 || slot == 3) {
                            u32x4 vv; vv.x = cvt_pk_bf16(acc[ai][1][m][0][0], acc[ai][1][m][0][1]); vv.y = cvt_pk_bf16(acc[ai][1][m][0][2], acc[ai][1][m][0][3]);
                            vv.z = cvt_pk_bf16(acc[ai][1][m][1][0], acc[ai][1][m][1][1]); vv.w = cvt_pk_bf16(acc[ai][1][m][1][2], acc[ai][1][m][1][3]);
                            *(u32x4*)(VAL + ((size_t)blk * 2 + (slot ? 1 : 0)) * DFF + ch0) = vv;
                        }
                    }
                }
                asm volatile("" ::: "memory");
            }
        }
        return;
    }
    if (E.mode <= 1) {
        unsigned short* base = (u.z == 1 && E.o1) ? (unsigned short*)E.o1 : (u.z == 2 && E.o2) ? (unsigned short*)E.o2 : (unsigned short*)E.o0 + (size_t)u.z * E.sCz;
        const int row0 = u.pm * BM + wr * 64 + fr, col0 = u.pn * BM + wc * 32 + 8 * fq;
        const int act = E.mode == 0 ? ((E.acts >> (4 * u.z)) & 15) : 0;
        f32x4 bv[2][2];
#pragma unroll
        for (int bj = 0; bj < 2; ++bj)
#pragma unroll
            for (int n = 0; n < 2; ++n) bv[bj][n] = (f32x4){0.f, 0.f, 0.f, 0.f};
        if (E.mode == 1) {
            const int zz = u.z + E.acts;
            const float* bp = (zz < 2 ? E.b0 + zz * D : E.b1 + (zz - 2) * D) + col0;
#pragma unroll
            for (int bj = 0; bj < 2; ++bj)
#pragma unroll
                for (int n = 0; n < 2; ++n) bv[bj][n] = *(const f32x4*)(bp + bj * HALF + 4 * n);
        }
#pragma unroll
        for (int ai = 0; ai < 2; ++ai)
#pragma unroll
            for (int m = 0; m < 4; ++m) {
                unsigned short* rowp = base + (size_t)(row0 + ai * HALF + m * 16) * E.ldc + col0;
#pragma unroll
                for (int bj = 0; bj < 2; ++bj) {
                    f32x4 v0 = acc[ai][bj][m][0] + bv[bj][0], v1 = acc[ai][bj][m][1] + bv[bj][1];
                    u32x4 w;
                    if (E.mode == 0) {
                        if (act == 1) {
#pragma unroll
                            for (int e = 0; e < 4; ++e) { v0[e] = tanhf_(v0[e]); v1[e] = tanhf_(v1[e]); }
                        } else if (act == 2) {
#pragma unroll
                            for (int e = 0; e < 4; ++e) { v0[e] = sigmoidf_(v0[e]); v1[e] = sigmoidf_(v1[e]); }
                        }
                        w.x = cvt_pk_bf16(v0[0], v0[1]); w.y = cvt_pk_bf16(v0[2], v0[3]); w.z = cvt_pk_bf16(v1[0], v1[1]); w.w = cvt_pk_bf16(v1[2], v1[3]);
                    } else {
                        const float sc = (u.z + E.acts < 2) ? 0.6065306597126334f : 1.0f;
#pragma unroll
                        for (int e = 0; e < 4; ++e) { v0[e] = sc * sigmoidf_(v0[e]); v1[e] = sc * sigmoidf_(v1[e]); }
                        w.x = cvt_pk_f16(v0[0], v0[1]); w.y = cvt_pk_f16(v0[2], v0[3]); w.z = cvt_pk_f16(v1[0], v1[1]); w.w = cvt_pk_f16(v1[2], v1[3]);
                    }
                    *(u32x4*)(rowp + bj * HALF) = w;
                }
                asm volatile("" ::: "memory");
            }
    } else {
        const int col0 = u.pn * BM + wc * 32 + 4 * fq;
        const int rowt = u.pm * BM;
        if (E.mode == 2) {
            float* base = (float*)E.o0;
#pragma unroll
            for (int ai = 0; ai < 2; ++ai)
#pragma unroll
                for (int m = 0; m < 4; ++m) {
                    float* rowp = base + (size_t)(rowt + ai * HALF + wr * 64 + m * 16 + fr) * E.ldc + col0;
#pragma unroll
                    for (int bj = 0; bj < 2; ++bj)
#pragma unroll
                        for (int n = 0; n < 2; ++n) *(f32x4*)(rowp + bj * HALF + n * 16) = acc[ai][bj][m][n];
                    asm volatile("" ::: "memory");
                }
        } else {
            const bool lat = rowt < NL;
            const int v = lat ? (rowt >> 12) : 4;
            const float* xin = lat ? E.xin_l + (size_t)rowt * D : E.xin_c + (size_t)(rowt - NL) * D;
            float* xout = lat ? E.xout_l + (size_t)rowt * D : E.xout_c + (size_t)(rowt - NL) * D;
            const float* gp = E.gate + (size_t)v * MODW + col0;
            f32x4 gv[2][2];
#pragma unroll
            for (int bj = 0; bj < 2; ++bj)
#pragma unroll
                for (int n = 0; n < 2; ++n) gv[bj][n] = *(const f32x4*)(gp + bj * HALF + n * 16);
#pragma unroll
            for (int ai = 0; ai < 2; ++ai)
#pragma unroll
                for (int mp = 0; mp < 4; mp += 2) {
                    f32x4 xi[2][2][2];
#pragma unroll
                    for (int m = 0; m < 2; ++m) {
                        const size_t off = (size_t)(ai * HALF + wr * 64 + (mp + m) * 16 + fr) * D + col0;
#pragma unroll
                        for (int bj = 0; bj < 2; ++bj)
#pragma unroll
                            for (int n = 0; n < 2; ++n) xi[m][bj][n] = *(const f32x4*)(xin + off + bj * HALF + n * 16);
                    }
                    asm volatile("" ::: "memory");
#pragma unroll
                    for (int m = 0; m < 2; ++m) {
                        const size_t off = (size_t)(ai * HALF + wr * 64 + (mp + m) * 16 + fr) * D + col0;
#pragma unroll
                        for (int bj = 0; bj < 2; ++bj)
#pragma unroll
                            for (int n = 0; n < 2; ++n) *(f32x4*)(xout + off + bj * HALF + n * 16) = xi[m][bj][n] + gv[bj][n] * acc[ai][bj][mp + m][n];
                    }
                    asm volatile("" ::: "memory");
                }
        }
    }
}

struct EpiSrc { int ph, gi; };
__device__ __forceinline__ void make_epi(const EpiSrc& es, Epi& E);
__device__ __forceinline__ void gemm_phase(LAS unsigned char* lds, const Gemm g, const StaticOrder& S, const EpiSrc es, const int perm, const int tid) {
    const int wid = __builtin_amdgcn_readfirstlane(tid >> 6), lane = tid & 63, wr = wid >> 2, wc = wid & 3, fr = lane & 15, fq = lane >> 4;
    const int K = g.K, nt = K / BK;
    unsigned voffA, voffB;
    { int R, C; stage_rc(tid * 16, R, C); const int Rb = (perm & 1) ? ((R & ~31) + perm32(R & 31)) : R;
        const int Ra = (perm & 2) ? ((R & ~63) + 4 * (R & 15) + ((R >> 4) & 3)) : R;
        voffA = (unsigned)(Ra * g.lda + C) * 2u; voffB = (unsigned)(Rb * g.ldb + C) * 2u; }
    const unsigned kstep = BK * 2;
    const unsigned hstepA = (unsigned)HALF * g.lda * 2, hstepB = (unsigned)HALF * g.ldb * 2;
    const unsigned tstepA = 2 * hstepA, tstepB = 2 * hstepB;
    const unsigned r64voffA = hstepA >> 1, r64voffB = hstepB >> 1; const unsigned voffA_ = voffA, voffB_ = voffB;
    const unsigned ldsw = (unsigned)wid * 1024u;
    const int aoff = lds_byte(wr * 64 + fr, fq * 8), boff = lds_byte(wc * 32 + fr, fq * 8);
#define PG8_SA(b, h) (((b) * 2 + (h)) * HTB)
#define PG8_SB(b, h) ((4 + (b) * 2 + (h)) * HTB)
#define PG8_STAGE(bufoff, gbase, voff) do { _Pragma("unroll") for (int _i = 0; _i < 2; ++_i) \
        __builtin_amdgcn_global_load_lds((const unsigned*)((const char*)(gbase) + _i * r64##voff + voff##_), (LAS unsigned*)(lds + (bufoff) + ldsw + _i * 8192), 16, 0, 0); } while (0)
#define PG8_LDA(dst, b, h) do { _Pragma("unroll") for (int m = 0; m < 4; ++m) _Pragma("unroll") for (int k = 0; k < 2; ++k) dst[m][k] = *(const LAS bf16x8*)(lds + PG8_SA(b, h) + aoff + m * 2048 + k * 1024); } while (0)
#define PG8_LDB(dst, b, h) do { _Pragma("unroll") for (int n = 0; n < 2; ++n) _Pragma("unroll") for (int k = 0; k < 2; ++k) dst[n][k] = *(const LAS bf16x8*)(lds + PG8_SB(b, h) + boff + n * 2048 + k * 1024); } while (0)
#define PG8_MMA(ai, bj, At, Bt) do { __builtin_amdgcn_s_setprio(1); _Pragma("unroll") for (int m = 0; m < 4; ++m) _Pragma("unroll") for (int n = 0; n < 2; ++n) _Pragma("unroll") for (int k = 0; k < 2; ++k) \
        acc[ai][bj][m][n] = __builtin_amdgcn_mfma_f32_16x16x32_bf16(Bt[n][k], At[m][k], acc[ai][bj][m][n], 0, 0, 0); __builtin_amdgcn_s_setprio(0); } while (0)
#define PG8_WAIT_V(n) asm volatile("s_waitcnt vmcnt(" #n ")" ::: "memory")
#define PG8_WAIT_L(n) asm volatile("s_waitcnt lgkmcnt(" #n ")" ::: "memory")
#define PG8_BAR __builtin_amdgcn_s_barrier()
#define PG8_SCHED __builtin_amdgcn_sched_barrier(0)
    Unit cur, nxt; int ui = 0;
    if (!S.next(0, cur)) return;
    f32x4 acc[2][2][4][2];
#pragma unroll
    for (int a = 0; a < 2; ++a)
#pragma unroll
        for (int b = 0; b < 2; ++b)
#pragma unroll
            for (int m = 0; m < 4; ++m)
#pragma unroll
                for (int n = 0; n < 2; ++n) acc[a][b][m][n] = (f32x4){0.f, 0.f, 0.f, 0.f};
    bf16x8 At[4][2], B0[2][2], B1[2][2];
    const char* cA = (const char*)g.A + (size_t)((unsigned)cur.z * (unsigned)g.sAz * 2u + (unsigned)cur.pm * tstepA); const char* cB = (const char*)g.Bt + (size_t)((unsigned)cur.z * (unsigned)g.sBz * 2u + (unsigned)cur.pn * tstepB);
    PG8_STAGE(PG8_SB(0, 0), cB, voffB); PG8_STAGE(PG8_SB(0, 1), cB + hstepB, voffB); PG8_STAGE(PG8_SA(0, 0), cA, voffA); PG8_STAGE(PG8_SA(0, 1), cA + hstepA, voffA);
    if (wr == 1) PG8_BAR;
    PG8_WAIT_V(2); PG8_BAR;
    PG8_STAGE(PG8_SB(1, 0), cB + kstep, voffB); PG8_STAGE(PG8_SA(1, 0), cA + kstep, voffA); PG8_STAGE(PG8_SB(1, 1), cB + hstepB + kstep, voffB);
    PG8_WAIT_V(6); PG8_BAR;
    for (;;) {
        const bool has_next = S.next(ui + 1, nxt);
        const char* nA = has_next ? (const char*)g.A + (size_t)((unsigned)nxt.z * (unsigned)g.sAz * 2u + (unsigned)nxt.pm * tstepA) : cA; const char* nB = has_next ? (const char*)g.Bt + (size_t)((unsigned)nxt.z * (unsigned)g.sBz * 2u + (unsigned)nxt.pn * tstepB) : cB;
        for (int t = 0; t < nt; t += 2) {
            const bool last = (t == nt - 2);
            const char* a1 = cA + (size_t)(t + 1) * kstep;
            const char* a2 = last ? nA : cA + (size_t)(t + 2) * kstep; const char* b2 = last ? nB : cB + (size_t)(t + 2) * kstep;
            const char* a3 = a2 + kstep; const char* b3 = b2 + kstep;
            PG8_LDB(B0, 0, 0); PG8_LDB(B1, 0, 1); PG8_SCHED; PG8_LDA(At, 0, 0); PG8_STAGE(PG8_SA(1, 1), a1 + hstepA, voffA);
            PG8_WAIT_V(8); PG8_WAIT_L(0); PG8_BAR; PG8_MMA(0, 0, At, B0); PG8_MMA(0, 1, At, B1); PG8_BAR; PG8_SCHED;
            PG8_LDA(At, 0, 1); PG8_STAGE(PG8_SB(0, 0), b2, voffB); PG8_STAGE(PG8_SB(0, 1), b2 + hstepB, voffB); PG8_STAGE(PG8_SA(0, 0), a2, voffA);
            PG8_WAIT_V(8); PG8_WAIT_L(0); PG8_BAR; PG8_MMA(1, 0, At, B0); PG8_MMA(1, 1, At, B1); PG8_BAR; PG8_SCHED;
            PG8_LDB(B0, 1, 0); PG8_LDB(B1, 1, 1); PG8_SCHED; PG8_LDA(At, 1, 0); PG8_STAGE(PG8_SA(0, 1), a2 + hstepA, voffA);
            PG8_WAIT_V(8); PG8_WAIT_L(0); PG8_BAR; PG8_MMA(0, 0, At, B0); PG8_MMA(0, 1, At, B1); PG8_BAR; PG8_SCHED;
            PG8_LDA(At, 1, 1); PG8_STAGE(PG8_SB(1, 0), b3, voffB); PG8_STAGE(PG8_SB(1, 1), b3 + hstepB, voffB); PG8_STAGE(PG8_SA(1, 0), a3, voffA);
            PG8_WAIT_V(8); PG8_WAIT_L(0); PG8_BAR; PG8_MMA(1, 0, At, B0); PG8_MMA(1, 1, At, B1); PG8_BAR; PG8_SCHED;
        }
        if (wr == 0) PG8_BAR;
        { Epi E; make_epi(es, E); epilogue(E, acc, cur, wr, wc, fr, fq); }
        if (!has_next) break;
#pragma unroll
        for (int a = 0; a < 2; ++a)
#pragma unroll
            for (int b = 0; b < 2; ++b)
#pragma unroll
                for (int m = 0; m < 4; ++m)
#pragma unroll
                    for (int n = 0; n < 2; ++n) acc[a][b][m][n] = (f32x4){0.f, 0.f, 0.f, 0.f};
        cur = nxt; cA = nA; cB = nB; ++ui;
        if (wr == 1) PG8_BAR;
    }
    PG8_WAIT_V(0);
    PG8_BAR;
#undef PG8_SA
#undef PG8_SB
#undef PG8_STAGE
#undef PG8_LDA
#undef PG8_LDB
#undef PG8_MMA
#undef PG8_WAIT_V
#undef PG8_WAIT_L
#undef PG8_BAR
#undef PG8_SCHED
}
}

__device__ __forceinline__ void transpose_item(const float* W, int K, int N, bf16_t* WT, int ldo, int row_off, LAS float* scr, int item, int lane, int ilv = 0) {
    const int nblk = N / 32, kb = item / nblk, nb = item % nblk, k0 = 64 * kb, n0 = 32 * nb;
    float tv[32];
    const float* wp = W + (size_t)(k0 + (lane >> 5)) * N + n0 + (lane & 31);
#pragma unroll
    for (int i = 0; i < 32; ++i) tv[i] = wp[(size_t)(2 * i) * N];
#pragma unroll
    for (int i = 0; i < 32; ++i) scr[(2 * i + (lane >> 5)) * 33 + (lane & 31)] = tv[i];
    asm volatile("s_waitcnt lgkmcnt(0)" ::: "memory");
    const int c = lane & 7;
#pragma unroll
    for (int j = 0; j < 4; ++j) { const int n = (lane >> 3) + 8 * j; const LAS float* s = scr + (8 * c) * 33 + n;
        u32x4 o; o.x = cvt_pk_bf16(s[0 * 33], s[1 * 33]); o.y = cvt_pk_bf16(s[2 * 33], s[3 * 33]); o.z = cvt_pk_bf16(s[4 * 33], s[5 * 33]); o.w = cvt_pk_bf16(s[6 * 33], s[7 * 33]);
        const int nn = n0 + n; const int orow = ilv ? (nn >= DFF ? (((nn - DFF) >> 7) * 256 + 128 + ((nn - DFF) & 127)) : ((nn >> 7) * 256 + (nn & 127))) : row_off + nn;
        *(u32x4*)(WT + (size_t)orow * ldo + k0 + 8 * c) = o; }
    asm volatile("s_waitcnt lgkmcnt(0)" ::: "memory");
}
#define TR(src, K_, N_, dst, ldo, roff) { const int items_ = ((K_) / 64) * ((N_) / 32); if (r < items_) { transpose_item((src), (K_), (N_), (dst), (ldo), (roff), scr, r, lane); continue; } r -= items_; }
#define TRI(src, K_, N_, dst, ldo) { const int items_ = ((K_) / 64) * ((N_) / 32); if (r < items_) { transpose_item((src), (K_), (N_), (dst), (ldo), 0, scr, r, lane, 1); continue; } r -= items_; }

__device__ __forceinline__ void adaln_tasks(const KP& P, LAS unsigned char* lds, const int tid, const int bx, const int G) {
    if (bx >= 192) return;
    LAS float* sv = (LAS float*)lds;
    LAS float* red = (LAS float*)(lds + 40960);
    for (int i = tid; i < 5 * D; i += 512) { const int v = i >> 11, k = i & 2047; const float x = v < 4 ? P.in(1)[v * D + k] : P.in(3)[k]; sv[i] = x * __builtin_amdgcn_rcpf(1.0f + __expf(-x)); }
    __syncthreads();
    float* MOD = (float*)(P.ws() + WS_MOD);
    for (int task = bx; task < 192; task += G) {
        const int li = task / 96, cb = task % 96, cg = tid & 31, ks = tid >> 5;
        const float* wp = P.in(4) + (size_t)li * D * MODW + (size_t)(ks * 128) * MODW + cb * 128 + cg * 4;
        f32x4 a0 = {0, 0, 0, 0}, a1 = a0, a2 = a0, a3 = a0, a4 = a0;
#pragma unroll 16
        for (int k = 0; k < 128; ++k) {
            const f32x4 w = *(const f32x4*)(wp + (size_t)k * MODW);
            const int kk = ks * 128 + k;
            a0 += w * sv[kk]; a1 += w * sv[D + kk]; a2 += w * sv[2 * D + kk]; a3 += w * sv[3 * D + kk]; a4 += w * sv[4 * D + kk];
        }
        LAS f32x4* rp = (LAS f32x4*)(red + ks * 640 + cg * 4);
        rp[0] = a0; rp[32] = a1; rp[64] = a2; rp[96] = a3; rp[128] = a4;
        __syncthreads();
        for (int o = tid; o < 640; o += 512) {
            float s = 0.f;
#pragma unroll
            for (int q = 0; q < 16; ++q) s += red[q * 640 + o];
            const int v = o >> 7, cc = o & 127, col = cb * 128 + cc;
            MOD[((size_t)li * 5 + v) * MODW + col] = s + P.in(5)[li * MODW + col];
        }
        __syncthreads();
    }
}

__device__ __forceinline__ const float* xrow(const float* xl, const float* xc, int r) { return r < NL ? xl + (size_t)r * D : xc + (size_t)(r - NL) * D; }
__device__ __forceinline__ float row_rstd(const float* xr, int lane) {
    const f32x4* p = (const f32x4*)xr + lane; float s = 0.f;
#pragma unroll
    for (int j = 0; j < 8; ++j) { const f32x4 v = p[64 * j]; s += (v.x * v.x + v.y * v.y) + (v.z * v.z + v.w * v.w); }
    return rsqrtf(wave_sum(s) * (1.0f / D) + 1e-6f);
}
__device__ __forceinline__ void modnorm_phase(const float* xl, const float* xc, const float* g, const float* mod, int shift_off, int scale_off, bf16_t* out, int nrows, int gw, int ngw, int lane) {
    for (int r0 = 4 * gw; r0 < nrows; r0 += 4 * ngw) {
        const float* xr = xrow(xl, xc, r0); const int v = r0 < NL ? (r0 >> 12) : 4;
        f32x4 x[4][8]; float ss[4];
#pragma unroll
        for (int i = 0; i < 4; ++i) {
            float s = 0.f;
#pragma unroll
            for (int j = 0; j < 8; ++j) { x[i][j] = *(const f32x4*)(xr + (size_t)i * D + 4 * lane + 256 * j); s += (x[i][j].x * x[i][j].x + x[i][j].y * x[i][j].y) + (x[i][j].z * x[i][j].z + x[i][j].w * x[i][j].w); }
            ss[i] = s;
        }
#pragma unroll
        for (int o = 1; o < 64; o <<= 1) {
#pragma unroll
            for (int i = 0; i < 4; ++i) ss[i] += __shfl_xor(ss[i], o);
        }
        float rs[4];
#pragma unroll
        for (int i = 0; i < 4; ++i) rs[i] = rsqrtf(ss[i] * (1.0f / D) + 1e-6f);
        const float* mv = mod + (size_t)v * MODW;
#pragma unroll
        for (int j = 0; j < 8; ++j) {
            const int col = 4 * lane + 256 * j;
            const f32x4 gg = *(const f32x4*)(g + col), sc = *(const f32x4*)(mv + scale_off + col), sh = *(const f32x4*)(mv + shift_off + col);
            const f32x4 A = gg * (sc + 1.0f);
#pragma unroll
            for (int i = 0; i < 4; ++i) {
                const f32x4 h = x[i][j] * rs[i] * A + sh;
                u32x2 w; w.x = cvt_pk_bf16(h.x, h.y); w.y = cvt_pk_bf16(h.z, h.w);
                *(u32x2*)(out + (size_t)(r0 + i) * D + col) = w;
            }
        }
    }
}
__device__ __forceinline__ void mix_phase(const KP& P, int gw, int ngw, int lane) {
    const float* mod = (const float*)(P.ws() + WS_MOD); const float* g = P.in(6); const float* mu = P.in(8);
    bf16_t* XS = (bf16_t*)(P.ws() + WS_BIG);
    for (int r0 = 4 * gw; r0 < T; r0 += 4 * ngw) {
        const bool lat = r0 < NL; const int t0 = lat ? (r0 & 4095) : ((r0 - NL) & 255), L = lat ? SEQ : CTXL, v = lat ? (r0 >> 12) : 4;
        const float* xr = xrow(P.in(0), P.in(2), r0);
        const bool hp = t0 > 0, hn = t0 + 4 < L;
        float ss[6];
#pragma unroll
        for (int i = 0; i < 6; ++i) {
            float s = 0.f;
            if ((i > 0 || hp) && (i < 5 || hn)) {
                const f32x4* p = (const f32x4*)(xr + (ptrdiff_t)(i - 1) * D) + lane;
#pragma unroll
                for (int j = 0; j < 8; ++j) { const f32x4 q = p[64 * j]; s += (q.x * q.x + q.y * q.y) + (q.z * q.z + q.w * q.w); }
            }
            ss[i] = s;
        }
#pragma unroll
        for (int o = 1; o < 64; o <<= 1) {
#pragma unroll
            for (int i = 0; i < 6; ++i) ss[i] += __shfl_xor(ss[i], o);
        }
        float rs[6];
#pragma unroll
        for (int i = 0; i < 6; ++i) rs[i] = rsqrtf(ss[i] * (1.0f / D) + 1e-6f);
        const float* mv = mod + (size_t)v * MODW;
#pragma unroll 1
        for (int j = 0; j < 8; ++j) {
            const int col = 4 * lane + 256 * j;
            const f32x4 gg = *(const f32x4*)(g + col), sc = *(const f32x4*)(mv + 2048 + col), sh = *(const f32x4*)(mv + col);
            const f32x4 A = gg * (sc + 1.0f);
            f32x4 h[6];
#pragma unroll
            for (int i = 0; i < 6; ++i) {
                h[i] = (f32x4){0.f, 0.f, 0.f, 0.f};
                if ((i > 0 || hp) && (i < 5 || hn)) { const f32x4 x = *(const f32x4*)(xr + (ptrdiff_t)(i - 1) * D + col); h[i] = x * rs[i] * A + sh; }
            }
            f32x4 m[6];
#pragma unroll
            for (int q = 0; q < 6; ++q) m[q] = *(const f32x4*)(mu + q * D + col);
#pragma unroll
            for (int i = 0; i < 4; ++i) {
                const f32x4 hc = h[i + 1], xx = (h[i] + h[i + 2]) * 0.5f - hc;
#pragma unroll
                for (int q = 0; q < 6; ++q) {
                    const f32x4 o = hc + xx * m[q];
                    u32x2 w; w.x = cvt_pk_bf16(o.x, o.y); w.y = cvt_pk_bf16(o.z, o.w);
                    constexpr int slot_of[6] = {0, 3, 1, 2, 4, 5};
                    *(u32x2*)(XS + (size_t)slot_of[q] * T * D + (size_t)(r0 + i) * D + col) = w;
                }
            }
        }
    }
}

__device__ __forceinline__ void readout_phase(const KP& P, int gw, int ngw, int lane) {
    const unsigned short* E = (const unsigned short*)(P.ws() + WS_BIG);
    const unsigned short* YF = E + 4 * (size_t)T * D; const unsigned short* YB = E + 5 * (size_t)T * D;
    const bf16_t* G = (const bf16_t*)(P.ws() + WS_BIG);
    bf16_t* Y2 = (bf16_t*)(P.ws() + WS_BIG + S68);
    const bf16_t* Vb = (const bf16_t*)(P.ws() + WS_KV + S68);
    const float* BON = (const float*)(P.ws() + WS_BON);
    const float* gnw = P.in(24); const float* gnb = P.in(25);
    for (int r = gw; r < T; r += ngw) {
#pragma unroll 1
        for (int it = 0; it < 4; it += 2) {
            u32x4 yf[2], yb[2], vv[2], gg[2]; float bon[2];
#pragma unroll
            for (int u = 0; u < 2; ++u) {
                const size_t off = (size_t)r * D + (it + u) * 512 + lane * 8;
                yf[u] = *(const u32x4*)(YF + off); yb[u] = *(const u32x4*)(YB + off); vv[u] = *(const u32x4*)(Vb + off); gg[u] = *(const u32x4*)(G + off);
                const int head = (it + u) * 8 + (lane >> 3);
                bon[u] = BON[(size_t)r * 32 + head] + BON[((size_t)T + r) * 32 + head];
            }
#pragma unroll
            for (int u = 0; u < 2; ++u) {
                const int col = (it + u) * 512 + lane * 8; const size_t off = (size_t)r * D + col;
                float y[8], v8[8], g8[8], gwc[8], gbc[8];
                { const f32x4 p = *(const f32x4*)(gnw + col), q = *(const f32x4*)(gnw + col + 4); gwc[0] = p.x; gwc[1] = p.y; gwc[2] = p.z; gwc[3] = p.w; gwc[4] = q.x; gwc[5] = q.y; gwc[6] = q.z; gwc[7] = q.w; }
                { const f32x4 p = *(const f32x4*)(gnb + col), q = *(const f32x4*)(gnb + col + 4); gbc[0] = p.x; gbc[1] = p.y; gbc[2] = p.z; gbc[3] = p.w; gbc[4] = q.x; gbc[5] = q.y; gbc[6] = q.z; gbc[7] = q.w; }
#pragma unroll
                for (int e = 0; e < 4; ++e) {
                    y[2 * e] = h_lo(yf[u][e]) + h_lo(yb[u][e]); y[2 * e + 1] = h_hi(yf[u][e]) + h_hi(yb[u][e]);
                    v8[2 * e] = bf_lo(vv[u][e]); v8[2 * e + 1] = bf_hi(vv[u][e]); g8[2 * e] = bf_lo(gg[u][e]); g8[2 * e + 1] = bf_hi(gg[u][e]);
                }
                float sy = 0.f;
#pragma unroll
                for (int e = 0; e < 8; ++e) sy += y[e];
                const float mean = red8(sy) * (1.0f / 64.0f);
                float sq = 0.f;
#pragma unroll
                for (int e = 0; e < 8; ++e) { const float dd = y[e] - mean; sq += dd * dd; }
                const float rstd = rsqrtf(red8(sq) * (1.0f / 64.0f) + 64e-5f);
                const float bonus = bon[u];
                float o[8];
#pragma unroll
                for (int e = 0; e < 8; ++e) o[e] = ((y[e] - mean) * rstd * gwc[e] + gbc[e] + bonus * v8[e]) * g8[e];
                u32x4 w; w.x = cvt_pk_bf16(o[0], o[1]); w.y = cvt_pk_bf16(o[2], o[3]); w.z = cvt_pk_bf16(o[4], o[5]); w.w = cvt_pk_bf16(o[6], o[7]);
                *(u32x4*)(Y2 + off) = w;
            }
        }
    }
}

__device__ __forceinline__ void conv_phase(const bf16_t* U, bf16_t* Gf, const float* cw, const float* cb, int nrows, int gtid, int ngt) {
    const long nitems = (long)(nrows / 8) * (DFF / 8);
    for (long it = gtid; it < nitems; it += ngt) {
        const int r0 = (int)(it / (DFF / 8)) * 8, c = (int)(it % (DFF / 8)) * 8;
        const bool lat = r0 < NL; const int t0 = lat ? (r0 & 4095) : ((r0 - NL) & 255), L = lat ? SEQ : CTXL;
        const bf16_t* up = U + (size_t)r0 * (2 * DFF) + c;
        u32x4 gt[10], vl[8];
        gt[0] = (u32x4){0, 0, 0, 0}; gt[9] = (u32x4){0, 0, 0, 0};
        if (t0 > 0) gt[0] = *(const u32x4*)(up - 2 * DFF);
        if (t0 + 8 < L) gt[9] = *(const u32x4*)(up + 8 * (2 * DFF));
#pragma unroll
        for (int i = 0; i < 8; ++i) { gt[i + 1] = *(const u32x4*)(up + (size_t)i * (2 * DFF)); vl[i] = *(const u32x4*)(up + (size_t)i * (2 * DFF) + DFF); }
        float w0[8], w1[8], w2[8], bb[8];
        { const f32x4 a = *(const f32x4*)(cw + c), b = *(const f32x4*)(cw + c + 4); w0[0] = a.x; w0[1] = a.y; w0[2] = a.z; w0[3] = a.w; w0[4] = b.x; w0[5] = b.y; w0[6] = b.z; w0[7] = b.w; }
        { const f32x4 a = *(const f32x4*)(cw + DFF + c), b = *(const f32x4*)(cw + DFF + c + 4); w1[0] = a.x; w1[1] = a.y; w1[2] = a.z; w1[3] = a.w; w1[4] = b.x; w1[5] = b.y; w1[6] = b.z; w1[7] = b.w; }
        { const f32x4 a = *(const f32x4*)(cw + 2 * DFF + c), b = *(const f32x4*)(cw + 2 * DFF + c + 4); w2[0] = a.x; w2[1] = a.y; w2[2] = a.z; w2[3] = a.w; w2[4] = b.x; w2[5] = b.y; w2[6] = b.z; w2[7] = b.w; }
        { const f32x4 a = *(const f32x4*)(cb + c), b = *(const f32x4*)(cb + c + 4); bb[0] = a.x; bb[1] = a.y; bb[2] = a.z; bb[3] = a.w; bb[4] = b.x; bb[5] = b.y; bb[6] = b.z; bb[7] = b.w; }
#pragma unroll
        for (int i = 0; i < 8; ++i) {
            float o[8];
#pragma unroll
            for (int e = 0; e < 4; ++e) {
                const float p0 = bf_lo(gt[i][e]), p1 = bf_hi(gt[i][e]), q0 = bf_lo(gt[i + 1][e]), q1 = bf_hi(gt[i + 1][e]), n0 = bf_lo(gt[i + 2][e]), n1 = bf_hi(gt[i + 2][e]);
                const float g0 = p0 * w0[2 * e] + q0 * w1[2 * e] + n0 * w2[2 * e] + bb[2 * e], g1 = p1 * w0[2 * e + 1] + q1 * w1[2 * e + 1] + n1 * w2[2 * e + 1] + bb[2 * e + 1];
                o[2 * e] = g0 * __builtin_amdgcn_rcpf(1.0f + __expf(-g0)) * bf_lo(vl[i][e]); o[2 * e + 1] = g1 * __builtin_amdgcn_rcpf(1.0f + __expf(-g1)) * bf_hi(vl[i][e]);
            }
            u32x4 w; w.x = cvt_pk_bf16(o[0], o[1]); w.y = cvt_pk_bf16(o[2], o[3]); w.z = cvt_pk_bf16(o[4], o[5]); w.w = cvt_pk_bf16(o[6], o[7]);
            *(u32x4*)(Gf + (size_t)(r0 + i) * DFF + c) = w;
        }
    }
}

__device__ __forceinline__ void fixup_phase(const bf16_t* RAW, const bf16_t* VAL, bf16_t* Gf, const float* cw, const float* cb, int nrows, int gtid, int ngt) {
    const int nitems = (nrows / 64) * 2 * (DFF / 8);
    for (int it = gtid; it < nitems; it += ngt) {
        const int c = (it % (DFF / 8)) * 8, be = it / (DFF / 8), edge = be & 1, blk = be >> 1;
        const int r = blk * 64 + (edge ? 63 : 0);
        const bool lat = r < NL; const int t = lat ? (r & 4095) : ((r - NL) & 255), L = lat ? SEQ : CTXL;
        u32x4 gp = {0, 0, 0, 0}, gn = {0, 0, 0, 0}, gc, vl;
        if (edge == 0) {
            if (t > 0) gp = *(const u32x4*)(RAW + ((size_t)(blk - 1) * 4 + 3) * DFF + c);
            gc = *(const u32x4*)(RAW + ((size_t)blk * 4 + 0) * DFF + c); gn = *(const u32x4*)(RAW + ((size_t)blk * 4 + 1) * DFF + c);
            vl = *(const u32x4*)(VAL + ((size_t)blk * 2 + 0) * DFF + c);
        } else {
            gp = *(const u32x4*)(RAW + ((size_t)blk * 4 + 2) * DFF + c); gc = *(const u32x4*)(RAW + ((size_t)blk * 4 + 3) * DFF + c);
            if (t < L - 1) gn = *(const u32x4*)(RAW + ((size_t)(blk + 1) * 4 + 0) * DFF + c);
            vl = *(const u32x4*)(VAL + ((size_t)blk * 2 + 1) * DFF + c);
        }
        float o[8];
#pragma unroll
        for (int e = 0; e < 4; ++e) {
#pragma unroll
            for (int hh = 0; hh < 2; ++hh) {
                const int ch = c + 2 * e + hh;
                const float p = hh ? bf_hi(gp[e]) : bf_lo(gp[e]), q = hh ? bf_hi(gc[e]) : bf_lo(gc[e]), n = hh ? bf_hi(gn[e]) : bf_lo(gn[e]), vv = hh ? bf_hi(vl[e]) : bf_lo(vl[e]);
                const float gt = p * cw[ch] + q * cw[DFF + ch] + n * cw[2 * DFF + ch] + cb[ch];
                o[2 * e + hh] = gt * __builtin_amdgcn_rcpf(1.0f + __expf(-gt)) * vv;
            }
        }
        u32x4 w; w.x = cvt_pk_bf16(o[0], o[1]); w.y = cvt_pk_bf16(o[2], o[3]); w.z = cvt_pk_bf16(o[4], o[5]); w.w = cvt_pk_bf16(o[6], o[7]);
        *(u32x4*)(Gf + (size_t)r * DFF + c) = w;
    }
}

__device__ __forceinline__ void mla_mid_phase(const KP& P, int gw, int ngw, int lane) {
    const bf16_t* CQ = (const bf16_t*)(P.ws() + WS_BIG + S68);
    bf16_t* CQn = (bf16_t*)(P.ws() + WS_BIG + 153 * MiB); bf16_t* CKVn = (bf16_t*)(P.ws() + WS_BIG + 170 * MiB); bf16_t* KR = (bf16_t*)(P.ws() + WS_BIG + 187 * MiB);
    const float* qn = P.in(27); const float* kvn = P.in(28);
    for (int r = gw; r < T; r += ngw) {
        const bf16_t* row = CQ + (size_t)r * 1280;
        u32x4 raw[2];
#pragma unroll
        for (int part = 0; part < 2; ++part) raw[part] = *(const u32x4*)(row + part * 512 + lane * 8);
        float ssv[2]; f32x4 av[2], bv[2];
#pragma unroll
        for (int part = 0; part < 2; ++part) {
            av[part] = (f32x4){bf_lo(raw[part].x), bf_hi(raw[part].x), bf_lo(raw[part].y), bf_hi(raw[part].y)};
            bv[part] = (f32x4){bf_lo(raw[part].z), bf_hi(raw[part].z), bf_lo(raw[part].w), bf_hi(raw[part].w)};
            const f32x4 a = av[part], b = bv[part];
            ssv[part] = (a.x * a.x + a.y * a.y) + (a.z * a.z + a.w * a.w) + (b.x * b.x + b.y * b.y) + (b.z * b.z + b.w * b.w);
        }
#pragma unroll
        for (int o = 1; o < 64; o <<= 1) { ssv[0] += __shfl_xor(ssv[0], o); ssv[1] += __shfl_xor(ssv[1], o); }
#pragma unroll
        for (int part = 0; part < 2; ++part) {
            const float rs = rsqrtf(ssv[part] * (1.0f / 512.0f) + 1e-6f);
            const float* gp = (part ? kvn : qn) + lane * 8;
            const f32x4 g0 = *(const f32x4*)gp, g1 = *(const f32x4*)(gp + 4);
            const f32x4 o0 = av[part] * rs * g0, o1 = bv[part] * rs * g1;
            u32x4 w; w.x = cvt_pk_bf16(o0.x, o0.y); w.y = cvt_pk_bf16(o0.z, o0.w); w.z = cvt_pk_bf16(o1.x, o1.y); w.w = cvt_pk_bf16(o1.z, o1.w);
            *(u32x4*)((part ? CKVn : CQn) + (size_t)r * 512 + lane * 8) = w;
        }
        if (lane < 32) {
            const int hf = lane >> 4, i = lane & 15;
            const float x1 = __uint_as_float((unsigned)row[1024 + hf * 32 + i] << 16), x2 = __uint_as_float((unsigned)row[1024 + hf * 32 + 16 + i] << 16);
            float o1 = x1, o2 = x2;
            if (r < NL) {
                const int t = r & 4095; const float pos = (float)(hf ? (t & 63) : (t >> 6));
                const float ang = pos * exp2f(-(float)i * (13.287712379549449f / 16.0f));
                const float cs = __cosf(ang), sn = __sinf(ang);
                o1 = x1 * cs - x2 * sn; o2 = x2 * cs + x1 * sn;
            }
            KR[(size_t)r * 64 + hf * 32 + i] = (bf16_t)(cvt_pk_bf16(o1, o1) & 0xffffu);
            KR[(size_t)r * 64 + hf * 32 + 16 + i] = (bf16_t)(cvt_pk_bf16(o2, o2) & 0xffffu);
        }
    }
}

__device__ __forceinline__ int scan_row(int chunk, int tk, int d, int b) {
    const int s = chunk * 32 + tk;
    if (chunk < 8) return NL + b * CTXL + (d ? (CTXL - 1 - s) : s);
    const int s2 = s - CTXL; return b * SEQ + (d ? (SEQ - 1 - s2) : s2);
}
__device__ __forceinline__ void scan_phase(const KP& P, LAS unsigned char* lds, const int tid, const int bx, const int G) {
    LAS float* buf = (LAS float*)lds;
    LAS float* ybuf = (LAS float*)(lds + 98304);
    const bf16_t* R = (const bf16_t*)P.out(); const bf16_t* Kb = (const bf16_t*)(P.ws() + WS_KV); const bf16_t* Vb = (const bf16_t*)(P.ws() + WS_KV + S68);
    const unsigned short* EA = (const unsigned short*)(P.ws() + WS_BIG);
    constexpr int NCH = (CTXL + SEQ) / 32;
    for (int u = bx; u < 256; u += G) {
        const int d = u & 1, h = (u >> 1) & 31, b = u >> 6;
        const unsigned short* Ed = EA + (size_t)d * T * D; const unsigned short* Ad = EA + (size_t)(2 + d) * T * D;
        unsigned short* Yd = (unsigned short*)(P.ws() + WS_BIG) + (size_t)(4 + d) * T * D;
        const int tk = tid >> 4, cg = tid & 15, ch = h * 64 + cg * 4;
        const f32x4 kkc = *(const f32x4*)(P.in(21) + ch), kac = *(const f32x4*)(P.in(22) + ch), rkc = *(const f32x4*)(P.in(23) + ch);
        float* BONd = (float*)(P.ws() + WS_BON) + (size_t)d * T * 32;
        const int v = tid >> 3, kc = tid & 7;
        f32x2 S[4];
#pragma unroll
        for (int i = 0; i < 4; ++i) S[i] = (f32x2){0.f, 0.f};
        u32x2 lr, lk, lv, le, la;
#define SC_LOAD(c) do { const size_t off_ = (size_t)scan_row((c), tk, d, b) * D + ch; lr = *(const u32x2*)(R + off_); lk = *(const u32x2*)(Kb + off_); lv = *(const u32x2*)(Vb + off_); \
            le = *(const u32x2*)(Ed + off_); la = *(const u32x2*)(Ad + off_); } while (0)
#define SC_WRITE(bi, cc) do { const f32x4 k4 = {bf_lo(lk.x), bf_hi(lk.x), bf_lo(lk.y), bf_hi(lk.y)}; const f32x4 kx = k4 * kkc; \
            const f32x4 a4 = {h_lo(la.x), h_hi(la.x), h_lo(la.y), h_hi(la.y)}; const f32x4 e4 = {h_lo(le.x), h_hi(le.x), h_lo(le.y), h_hi(le.y)}; \
            const f32x4 kd = k4 * ((a4 - 1.0f) * kac + 1.0f); \
            const f32x4 rq_ = (f32x4){bf_lo(lr.x), bf_hi(lr.x), bf_lo(lr.y), bf_hi(lr.y)} * kd * rkc; \
            float ss_ = (kx.x * kx.x + kx.y * kx.y) + (kx.z * kx.z + kx.w * kx.w), bo_ = (rq_.x + rq_.y) + (rq_.z + rq_.w); \
            ss_ = red16(ss_); bo_ = red16(bo_);        \
            if (cg == 0) BONd[(size_t)scan_row((cc), tk, d, b) * 32 + h] = bo_;        \
            const float inv_ = rsqrtf(fmaxf(ss_, 1e-24f)); const f32x4 kkv = kx * inv_;        \
            const f32x4 bb = kkv * a4; \
            const f32x4 ww = {__expf(-e4.x), __expf(-e4.y), __expf(-e4.z), __expf(-e4.w)}; \
            LAS float* bp_ = buf + (bi) * 12288 + tk * 384 + cg * 4; \
            *(LAS f32x4*)(bp_) = ww; *(LAS f32x4*)(bp_ + 64) = kd; *(LAS f32x4*)(bp_ + 128) = -kkv; *(LAS f32x4*)(bp_ + 192) = bb; \
            *(LAS f32x4*)(bp_ + 256) = (f32x4){bf_lo(lr.x), bf_hi(lr.x), bf_lo(lr.y), bf_hi(lr.y)}; *(LAS f32x4*)(bp_ + 320) = (f32x4){bf_lo(lv.x), bf_hi(lv.x), bf_lo(lv.y), bf_hi(lv.y)}; } while (0)
        __syncthreads();
        SC_LOAD(0); SC_WRITE(0, 0);
        __syncthreads();
#pragma unroll 1
        for (int c = 0; c < NCH; ++c) {
            if (c + 1 < NCH) SC_LOAD(c + 1);
            const LAS float* cb = buf + (c & 1) * 12288 + kc * 8;
#pragma unroll 4
            for (int s = 0; s < 32; ++s) {
                const LAS float* p = cb + s * 384;
                const f32x4 w0 = *(const LAS f32x4*)(p), w1 = *(const LAS f32x4*)(p + 4);
                const f32x4 k0 = *(const LAS f32x4*)(p + 64), k1 = *(const LAS f32x4*)(p + 68);
                const f32x4 a0 = *(const LAS f32x4*)(p + 128), a1 = *(const LAS f32x4*)(p + 132);
                const f32x4 b0 = *(const LAS f32x4*)(p + 192), b1 = *(const LAS f32x4*)(p + 196);
                const f32x4 r0 = *(const LAS f32x4*)(p + 256), r1 = *(const LAS f32x4*)(p + 260);
                const float vv = buf[(c & 1) * 12288 + s * 384 + 320 + v];
                f32x2 sa2 = S[0] * (f32x2){a0.x, a0.y};
                sa2 += S[1] * (f32x2){a0.z, a0.w}; sa2 += S[2] * (f32x2){a1.x, a1.y}; sa2 += S[3] * (f32x2){a1.z, a1.w};
                const float sa = red8(sa2.x + sa2.y);
                const f32x2 sav = {sa, sa}, vv2 = {vv, vv};
                S[0] = S[0] * (f32x2){w0.x, w0.y} + sav * (f32x2){b0.x, b0.y} + vv2 * (f32x2){k0.x, k0.y};
                S[1] = S[1] * (f32x2){w0.z, w0.w} + sav * (f32x2){b0.z, b0.w} + vv2 * (f32x2){k0.z, k0.w};
                S[2] = S[2] * (f32x2){w1.x, w1.y} + sav * (f32x2){b1.x, b1.y} + vv2 * (f32x2){k1.x, k1.y};
                S[3] = S[3] * (f32x2){w1.z, w1.w} + sav * (f32x2){b1.z, b1.w} + vv2 * (f32x2){k1.z, k1.w};
                f32x2 y2 = S[0] * (f32x2){r0.x, r0.y};
                y2 += S[1] * (f32x2){r0.z, r0.w}; y2 += S[2] * (f32x2){r1.x, r1.y}; y2 += S[3] * (f32x2){r1.z, r1.w};
                const float y = red8(y2.x + y2.y);
                if (kc == 0) ybuf[s * 64 + v] = y;
            }
            __syncthreads();
            {
                const f32x4 y4 = *(const LAS f32x4*)(ybuf + tk * 64 + cg * 4);
                u32x2 w; w.x = cvt_pk_f16(y4.x, y4.y); w.y = cvt_pk_f16(y4.z, y4.w);
                *(u32x2*)(Yd + (size_t)scan_row(c, tk, d, b) * D + ch) = w;
            }
            if (c + 1 < NCH) SC_WRITE((c + 1) & 1, c + 1);
            __syncthreads();
        }
#undef SC_LOAD
#undef SC_WRITE
    }
}

namespace att {
constexpr float SCALE = 0.07216878364870323f;
constexpr float THR = 8.f;
constexpr int SHM_T = 16384;
#define KSWZ(row, colB) ((row) * 256 + ((colB) ^ (((row) & 7) << 4)))
#define SBAR() __builtin_amdgcn_sched_barrier(0)
__device__ __forceinline__ int crow(int r, int hi) { return (r & 3) + 8 * (r >> 2) + 4 * hi; }
__device__ __forceinline__ void partialSM(f32x16& p0, f32x16& p1, float& m_reg, float& mn, float& alpha) {
    constexpr float C = SCALE * 1.4426950408889634f;
    float pmax = p0[0];
#pragma unroll
    for (int r = 1; r < 16; ++r) pmax = fmaxf(pmax, p0[r]);
#pragma unroll
    for (int r = 0; r < 16; ++r) pmax = fmaxf(pmax, p1[r]);
    { auto rr = __builtin_amdgcn_permlane32_swap(__float_as_uint(pmax), __float_as_uint(pmax), false, false);
      pmax = fmaxf(__uint_as_float(rr[0]), __uint_as_float(rr[1])); }
    if (__builtin_expect(__all(pmax - m_reg <= THR / SCALE), 1)) { mn = m_reg; alpha = 1.f; }
    else { mn = fmaxf(m_reg, pmax); alpha = __builtin_amdgcn_exp2f((m_reg - mn) * C); m_reg = mn; }
    const float mnC = -mn * C;
#pragma unroll
    for (int r = 0; r < 16; ++r) p0[r] = __builtin_amdgcn_exp2f(fmaf(p0[r], C, mnC));
#pragma unroll
    for (int r = 0; r < 16; ++r) p1[r] = __builtin_amdgcn_exp2f(fmaf(p1[r], C, mnC));
}
__device__ __forceinline__ void finishSM(f32x16& p0, f32x16& p1, float alpha, float& l_reg, bf16x8& pa0, bf16x8& pa1, bf16x8& pa2, bf16x8& pa3) {
    float ps = 0;
#pragma unroll
    for (int r = 0; r < 16; ++r) ps += p0[r];
#pragma unroll
    for (int r = 0; r < 16; ++r) ps += p1[r];
    { auto rr = __builtin_amdgcn_permlane32_swap(__float_as_uint(ps), __float_as_uint(ps), false, false);
      ps = __uint_as_float(rr[0]) + __uint_as_float(rr[1]); }
    l_reg = l_reg * alpha + ps;
#define PK4(P, BASE, OUT) do { unsigned a0 = cvt_pk_bf16(P[BASE + 0], P[BASE + 1]), a1 = cvt_pk_bf16(P[BASE + 2], P[BASE + 3]);   \
    unsigned b0 = cvt_pk_bf16(P[BASE + 4], P[BASE + 5]), b1 = cvt_pk_bf16(P[BASE + 6], P[BASE + 7]);                              \
    auto r0 = __builtin_amdgcn_permlane32_swap(a0, b0, false, false); auto r1 = __builtin_amdgcn_permlane32_swap(a1, b1, false, false); \
    u32x4 w = {r0[0], r1[0], r0[1], r1[1]}; OUT = __builtin_bit_cast(bf16x8, w); } while (0)
    PK4(p0, 0, pa0); PK4(p0, 8, pa1); PK4(p1, 0, pa2); PK4(p1, 8, pa3);
#undef PK4
}
__device__ __forceinline__ void qkt(f32x16& p0, f32x16& p1, const char* Kn, const char* Kr, const bf16x8* qr, int r32, int hi) {
    p0 = f32x16{}; p1 = f32x16{};
#pragma unroll
    for (int d0 = 0; d0 < 8; ++d0) { const int cb = (d0 * 16 + hi * 8) * 2;
        const bf16x8 b0 = *reinterpret_cast<const bf16x8*>(Kn + KSWZ(r32, cb));
        const bf16x8 b1 = *reinterpret_cast<const bf16x8*>(Kn + KSWZ(32 + r32, cb));
        p0 = __builtin_amdgcn_mfma_f32_32x32x16_bf16(b0, qr[d0], p0, 0, 0, 0);
        p1 = __builtin_amdgcn_mfma_f32_32x32x16_bf16(b1, qr[d0], p1, 0, 0, 0); }
#pragma unroll
    for (int d0 = 0; d0 < 4; ++d0) { const int cb = (d0 * 16 + hi * 8) * 2;
        const bf16x8 b0 = *reinterpret_cast<const bf16x8*>(Kr + KSWZ(r32, cb));
        const bf16x8 b1 = *reinterpret_cast<const bf16x8*>(Kr + KSWZ(32 + r32, cb));
        p0 = __builtin_amdgcn_mfma_f32_32x32x16_bf16(b0, qr[8 + d0], p0, 0, 0, 0);
        p1 = __builtin_amdgcn_mfma_f32_32x32x16_bf16(b1, qr[8 + d0], p1, 0, 0, 0); }
}
__device__ __forceinline__ int v_st(int k, int c) { const int kk = (k & ~0xC) | ((k & 4) << 1) | ((k & 8) >> 1); return ((kk >> 3) * 4 + (c >> 5)) * 512 + ((kk & 7) * 32 + (c & 31)) * 2; }
__device__ __forceinline__ int v_rd_base(int lane) { return ((lane & 3) << 3) | (((lane >> 2) & 3) << 6) | (((lane >> 4) & 1) << 5) | (((lane >> 5) & 1) << 8); }
constexpr int v_rd_off(int d0, int ks, int half) { return d0 * 512 + ks * 4096 + half * 2048; }
template <int OFF> __device__ __forceinline__ s16x4 tr_read(int vb) {
    s16x4 r; asm volatile("ds_read_b64_tr_b16 %0, %1 offset:%2" : "=&v"(r) : "v"(vb), "i"(OFF) : "memory"); return r;
}
template <int D0> __device__ __forceinline__ void pv_one(f32x16& od, int vb, bf16x8 pa0, bf16x8 pa1, bf16x8 pa2, bf16x8 pa3) {
    const s16x4 l0 = tr_read<v_rd_off(D0, 0, 0)>(vb), h0 = tr_read<v_rd_off(D0, 0, 1)>(vb), l1 = tr_read<v_rd_off(D0, 1, 0)>(vb), h1 = tr_read<v_rd_off(D0, 1, 1)>(vb);
    const s16x4 l2 = tr_read<v_rd_off(D0, 2, 0)>(vb), h2 = tr_read<v_rd_off(D0, 2, 1)>(vb), l3 = tr_read<v_rd_off(D0, 3, 0)>(vb), h3 = tr_read<v_rd_off(D0, 3, 1)>(vb);
    asm volatile("s_waitcnt lgkmcnt(0)" ::: "memory"); SBAR();
#define PK(L, H) (bf16x8){L[0], L[1], L[2], L[3], H[0], H[1], H[2], H[3]}
    od = __builtin_amdgcn_mfma_f32_32x32x16_bf16(pa0, PK(l0, h0), od, 0, 0, 0);
    od = __builtin_amdgcn_mfma_f32_32x32x16_bf16(pa1, PK(l1, h1), od, 0, 0, 0);
    od = __builtin_amdgcn_mfma_f32_32x32x16_bf16(pa2, PK(l2, h2), od, 0, 0, 0);
    od = __builtin_amdgcn_mfma_f32_32x32x16_bf16(pa3, PK(l3, h3), od, 0, 0, 0);
#undef PK
}
__device__ __forceinline__ void pv_d0(f32x16* o, int vb, bf16x8 pa0, bf16x8 pa1, bf16x8 pa2, bf16x8 pa3) {
    pv_one<0>(o[0], vb, pa0, pa1, pa2, pa3); pv_one<1>(o[1], vb, pa0, pa1, pa2, pa3); pv_one<2>(o[2], vb, pa0, pa1, pa2, pa3); pv_one<3>(o[3], vb, pa0, pa1, pa2, pa3);
}
__device__ __forceinline__ long keyrow(int j, int b) { return j < 4 ? (long)NL + b * CTXL + j * 64 : (long)b * SEQ + (j - 4) * 64; }

__device__ __forceinline__ void attn_unit(const bf16_t* Q, const bf16_t* KV, const bf16_t* KR, bf16_t* O, int b, int h, int qb, char* lds, const int tid) {
    const int wid = tid >> 6, lane = tid & 63, r32 = lane & 31, hi = lane >> 5;
    char* V_lds = lds; char* Kn_lds = lds + 2 * SHM_T; char* Kr_lds = lds + 4 * SHM_T;
    float* wsf = (float*)(lds + 6 * SHM_T) + wid * 64; float* li_l = wsf; float* al_l = wsf + 32;
    float m_reg = -1e30f, l_reg = 0; f32x16 o[4] = {}; bf16x8 qr[12];
    const int tq = qb * 256 + wid * 32 + r32;
    const bf16_t* Qw = Q + ((size_t)b * SEQ + tq) * 3072 + h * 192 + hi * 8;
#pragma unroll
    for (int d0 = 0; d0 < 12; ++d0) qr[d0] = *reinterpret_cast<const bf16x8*>(Qw + d0 * 16);
#pragma unroll
    for (int ax = 0; ax < 2; ++ax) {
        const float pos = (float)(ax ? (tq & 63) : (tq >> 6));
        u32x4 w1 = __builtin_bit_cast(u32x4, qr[8 + 2 * ax]), w2 = __builtin_bit_cast(u32x4, qr[9 + 2 * ax]);
#pragma unroll
        for (int e2 = 0; e2 < 4; ++e2) {
            float o1[2], o2[2];
#pragma unroll
            for (int hh = 0; hh < 2; ++hh) {
                const int i = hi * 8 + e2 * 2 + hh;
                const float ang = pos * exp2f(-(float)i * (13.287712379549449f / 16.0f));
                const float cs = __cosf(ang), sn = __sinf(ang);
                const float x1 = hh ? bf_hi(w1[e2]) : bf_lo(w1[e2]), x2 = hh ? bf_hi(w2[e2]) : bf_lo(w2[e2]);
                o1[hh] = x1 * cs - x2 * sn; o2[hh] = x2 * cs + x1 * sn;
            }
            w1[e2] = cvt_pk_bf16(o1[0], o1[1]); w2[e2] = cvt_pk_bf16(o2[0], o2[1]);
        }
        qr[8 + 2 * ax] = __builtin_bit_cast(bf16x8, w1); qr[9 + 2 * ax] = __builtin_bit_cast(bf16x8, w2);
    }
    const int sr = tid >> 4, sc = (tid & 15) * 8, vst0 = v_st(sr, sc), vst1 = v_st(32 + sr, sc);
    const int krr = tid >> 3, krc = (tid & 7) * 8;
    const int vb0 = (int)(uintptr_t)V_lds + v_rd_base(lane);
    const bf16_t* Kh = KV + h * 256; const bf16_t* Vh = KV + h * 256 + 128;
    bf16x8 sv0, sv1, sk0, sk1, skr;
#define SLOAD(j) do { const long k0_ = keyrow((j), b); sv0 = *reinterpret_cast<const bf16x8*>(Vh + (k0_ + sr) * 4096 + sc); sv1 = *reinterpret_cast<const bf16x8*>(Vh + (k0_ + 32 + sr) * 4096 + sc); \
        sk0 = *reinterpret_cast<const bf16x8*>(Kh + (k0_ + sr) * 4096 + sc); sk1 = *reinterpret_cast<const bf16x8*>(Kh + (k0_ + 32 + sr) * 4096 + sc); \
        skr = *reinterpret_cast<const bf16x8*>(KR + (k0_ + krr) * 64 + krc); } while (0)
#define SWRITE(bi) do { *(bf16x8*)(V_lds + (bi) * SHM_T + vst0) = sv0; *(bf16x8*)(V_lds + (bi) * SHM_T + vst1) = sv1; \
        *(bf16x8*)(Kn_lds + (bi) * SHM_T + KSWZ(sr, sc * 2)) = sk0; *(bf16x8*)(Kn_lds + (bi) * SHM_T + KSWZ(32 + sr, sc * 2)) = sk1; \
        *(bf16x8*)(Kr_lds + (bi) * SHM_T + KSWZ(krr, krc * 2)) = skr; } while (0)
#define RESC(a) do { if (__any((a) < 1.f)) { if (hi == 0) al_l[r32] = (a); asm volatile("s_waitcnt lgkmcnt(0)" ::: "memory"); \
        _Pragma("unroll") for (int d_ = 0; d_ < 4; ++d_) _Pragma("unroll") for (int r_ = 0; r_ < 16; ++r_) o[d_][r_] *= al_l[crow(r_, hi)]; } } while (0)
    constexpr int NT = (CTXL + SEQ) / 64;
    __syncthreads();
    SLOAD(0); SWRITE(0); __syncthreads();
#pragma unroll 1
    for (int j = 0; j < NT; ++j) {
        const int bi = j & 1;
        if (j + 1 < NT) SLOAD(j + 1);
        f32x16 p0, p1; float mn, alpha; bf16x8 pa0, pa1, pa2, pa3;
        qkt(p0, p1, Kn_lds + bi * SHM_T, Kr_lds + bi * SHM_T, qr, r32, hi);
        partialSM(p0, p1, m_reg, mn, alpha);
        finishSM(p0, p1, alpha, l_reg, pa0, pa1, pa2, pa3);
        RESC(alpha);
        SBAR();
        pv_d0(o, vb0 + bi * SHM_T, pa0, pa1, pa2, pa3);
        if (j + 1 < NT) SWRITE(bi ^ 1);
        __syncthreads();
    }
    if (hi == 0) li_l[r32] = l_reg; asm volatile("s_waitcnt lgkmcnt(0)" ::: "memory");
    float rli[16];
#pragma unroll
    for (int r = 0; r < 16; ++r) rli[r] = __builtin_amdgcn_rcpf(li_l[crow(r, hi)]);
    bf16_t* Ow = O + ((size_t)b * SEQ + qb * 256 + wid * 32) * D + h * 128;
#pragma unroll
    for (int r = 0; r < 16; ++r) { const int orow = crow(r, hi);
#pragma unroll
        for (int d0 = 0; d0 < 4; ++d0) { const float val = o[d0][r] * rli[r]; Ow[(size_t)orow * D + d0 * 32 + r32] = (bf16_t)(cvt_pk_bf16(val, val) & 0xffffu); } }
#undef SLOAD
#undef SWRITE
#undef RESC
}
#undef KSWZ
#undef SBAR
}


#define XB_TMO      128
#define XB_XCNT(j)  (256  + 64 * (j))
#define XB_XSUB(j)  (1280 + 64 * (j))
#define XB_XGEN(j)  (2304 + 64 * (j))
#define XB_TOP      3328
#define XB_TOPGEN   3392
#define XCD_BAR_WORDS 3456
#define XB_SPIN_CAP (1u << 22)
__device__ __forceinline__ unsigned xb_ld(unsigned* p)              { return __hip_atomic_load(p, __ATOMIC_RELAXED, __HIP_MEMORY_SCOPE_AGENT); }
__device__ __forceinline__ unsigned xb_add(unsigned* p, unsigned v) { return __hip_atomic_fetch_add(p, v, __ATOMIC_RELAXED, __HIP_MEMORY_SCOPE_AGENT); }
__device__ __forceinline__ unsigned xb_xcc_id() { return (unsigned)__builtin_amdgcn_s_getreg((3 << 11) | 20) & 0xFu; }
#define XB_SPIN(cond, bar) do { unsigned _sp = 0; while (cond) { __builtin_amdgcn_s_sleep(1); \
    if ((++_sp & 255u) == 0u) { if (xb_ld(&(bar)[XB_TMO])) break; if (_sp > XB_SPIN_CAP) { atomicAdd(&(bar)[XB_TMO], 1u); break; } } } } while (0)
struct XcdBarrier { unsigned* bar; unsigned x; volatile LAS unsigned* st; };
__device__ __forceinline__ void xcd_barrier_complete(unsigned* bar, unsigned x, unsigned& nloc, unsigned& nx) {
    const unsigned G = gridDim.x * gridDim.y * gridDim.z;
    unsigned sum, cnt, mine, sp = 0u;
    for (;;) {
        sum = 0u; cnt = 0u; mine = 0u;
#pragma unroll
        for (unsigned j = 0; j < 16; ++j) { const unsigned c = xb_ld(&bar[XB_XCNT(j)]); sum += c; cnt += (c > 0u) ? 1u : 0u; mine = (j == x) ? c : mine; }
        if (sum == G) break;
        __builtin_amdgcn_s_sleep(1);
        if ((++sp & 255u) == 0u) { if (xb_ld(&bar[XB_TMO])) break; if (sp > XB_SPIN_CAP) { atomicAdd(&bar[XB_TMO], 1u); break; } }
    }
    nloc = mine > 0u ? mine : 1u; nx = cnt > 0u ? cnt : 1u;
}
__device__ __forceinline__ void xcd_barrier(const XcdBarrier& b) {
    asm volatile("s_waitcnt vmcnt(0)" ::: "memory");
    __syncthreads();
    if (threadIdx.x == 0) {
        unsigned* bar = b.bar;
        __builtin_amdgcn_s_waitcnt(0);
        unsigned nloc = b.st[0], nx = b.st[1];
        if (nloc == 0u) { xcd_barrier_complete(bar, b.x, nloc, nx); b.st[0] = nloc; b.st[1] = nx; }
        const unsigned old = xb_add(&bar[XB_XSUB(b.x)], 1u);
        const unsigned gen = old / nloc;
        if (old + 1u == (gen + 1u) * nloc) {
            __builtin_amdgcn_fence(__ATOMIC_RELEASE, "agent");
            asm volatile("s_waitcnt vmcnt(0)" ::: "memory");
            const unsigned og = xb_add(&bar[XB_TOP], 1u);
            const unsigned tg = og / nx;
            if (og + 1u == (tg + 1u) * nx) xb_add(&bar[XB_TOPGEN], 1u);
            else XB_SPIN(xb_ld(&bar[XB_TOPGEN]) == tg, bar);
            __builtin_amdgcn_fence(__ATOMIC_ACQUIRE, "agent");
            xb_add(&bar[XB_XGEN(b.x)], 1u);
            asm volatile("s_waitcnt vmcnt(0)" ::: "memory");
        } else {
            XB_SPIN(xb_ld(&bar[XB_XGEN(b.x)]) == gen, bar);
            __builtin_amdgcn_fence(__ATOMIC_ACQUIRE, "agent");
            asm volatile("s_waitcnt vmcnt(0)" ::: "memory");
        }
    }
    __syncthreads();
}

__device__ __forceinline__ void setup_gemm(const KP& P, int ph, int gi, pg8::Gemm& g, pg8::Epi& e) {
    unsigned char* ws = P.ws(); const bf16_t* W = (const bf16_t*)(ws + WS_W); bf16_t* BIG = (bf16_t*)(ws + WS_BIG);
    const float* MOD = (const float*)(ws + WS_MOD);
    e.mode = 0; e.perm = 1; e.acts = 0; e.o0 = nullptr; e.o1 = nullptr; e.o2 = nullptr; e.sCz = 0; e.ldc = D; e.b0 = nullptr; e.b1 = nullptr;
    g.sAz = 0; g.sBz = 0; g.nz = 1; g.M = T;
    const size_t TD = (size_t)T * D;
    switch (ph) {
    case 2:
        if (gi == 0) {
            g.A = BIG; g.lda = D; g.sAz = (int)TD; g.Bt = W + W_RKV / 2; g.ldb = D; g.sBz = D * D; g.N = D; g.K = D; g.nz = 3;
            e.o0 = P.out(); e.o1 = ws + WS_KV; e.o2 = ws + WS_KV + S68; e.ldc = D;
        } else {
            g.A = BIG + 3 * TD; g.lda = D; g.sAz = (int)TD; g.Bt = W + W_L1 / 2; g.ldb = D; g.sBz = 256 * D; g.N = 256; g.K = D; g.nz = 3;
            e.o0 = (unsigned char*)P.out() + S68; e.sCz = (long)T * 256; e.ldc = 256; e.acts = 1 | (0 << 4) | (2 << 8);
        }
        break;
    case 3:
        g.A = (const bf16_t*)((unsigned char*)P.out() + S68) + (size_t)gi * T * 256; g.lda = 256; g.sAz = 64; g.Bt = W + W_L2 / 2 + (size_t)gi * 2 * D * 256; g.ldb = 256; g.sBz = D * 256 + 64; g.N = D; g.K = 128; g.nz = 2;
        e.mode = 1; e.acts = 2 * gi; e.o0 = BIG + (size_t)gi * 2 * TD; e.sCz = (long)TD; e.ldc = D; e.b0 = P.in(13); e.b1 = P.in(16);
        break;
    case 5:
        g.A = (const bf16_t*)((unsigned char*)P.out() + S68) + 2 * (size_t)T * 256; g.lda = 256; g.Bt = W + W_G2 / 2; g.ldb = 256; g.N = D; g.K = 256;
        e.o0 = BIG; e.ldc = D;
        break;
    case 7:
        g.A = BIG + TD; g.lda = D; g.Bt = W + W_RWO / 2; g.ldb = D; g.N = D; g.K = D;
        e.mode = 3; e.perm = 0; e.xin_l = P.in(0); e.xin_c = P.in(2); e.xout_l = P.out(); e.xout_c = (float*)(ws + WS_XC); e.gate = MOD + 4096;
        break;
    case 9:
        g.A = (const bf16_t*)(ws + WS_KV); g.lda = D; g.Bt = W + W_UP / 2; g.ldb = D; g.N = 2 * DFF; g.K = D;
        e.mode = 4; e.o0 = ws + WS_GF; e.o1 = ws + WS_BIG; e.o2 = ws + WS_BIG + 16 * MiB; e.b0 = P.in(33); e.b1 = P.in(34);
        break;
    case 11:
        g.A = (const bf16_t*)(ws + WS_GF); g.lda = DFF; g.Bt = W + W_DN / 2; g.ldb = DFF; g.N = D; g.K = DFF;
        e.mode = 3; e.perm = 0; e.xin_l = P.out(); e.xin_c = (const float*)(ws + WS_XC); e.xout_l = P.out(); e.xout_c = (float*)(ws + WS_XC); e.gate = MOD + 10240;
        break;
    case 13:
        g.A = BIG; g.lda = D; g.Bt = W + W_MLD / 2; g.ldb = D; g.N = 1280; g.K = D;
        e.mode = 0; e.perm = 1; e.o0 = ws + WS_BIG + S68; e.ldc = 1280;
        break;
    case 15:
        if (gi == 0) {
            g.A = (const bf16_t*)(ws + WS_BIG + 153 * MiB); g.lda = 512; g.Bt = W + W_UQ / 2; g.ldb = 512; g.M = NL; g.N = 3072; g.K = 512;
            e.o0 = ws + WS_BIG + 190 * MiB; e.ldc = 3072;
        } else {
            g.A = (const bf16_t*)(ws + WS_BIG + 170 * MiB); g.lda = 512; g.Bt = W + W_UKV / 2; g.ldb = 512; g.N = 4096; g.K = 512;
            e.o0 = ws + WS_KV; e.ldc = 4096;
        }
        break;
    case 17:
        g.A = BIG; g.lda = D; g.Bt = W + W_MLO / 2; g.ldb = D; g.M = NL; g.N = D; g.K = D;
        e.mode = 3; e.perm = 0; e.xin_l = P.out(); e.xin_c = (const float*)(ws + WS_XC); e.xout_l = P.out(); e.xout_c = (float*)(ws + WS_XC); e.gate = MOD + 5 * MODW + 4096;
        break;
    case 19:
        g.A = (const bf16_t*)(ws + WS_KV); g.lda = D; g.Bt = W + W_UP / 2; g.ldb = D; g.M = NL; g.N = 2 * DFF; g.K = D;
        e.mode = 4; e.o0 = ws + WS_GF; e.o1 = ws + WS_BIG; e.o2 = ws + WS_BIG + 16 * MiB; e.b0 = P.in(33) + 3 * DFF; e.b1 = P.in(34) + DFF;
        break;
    default:
        g.A = (const bf16_t*)(ws + WS_GF); g.lda = DFF; g.Bt = W + W_DN / 2; g.ldb = DFF; g.M = NL; g.N = D; g.K = DFF;
        e.mode = 3; e.perm = 0; e.xin_l = P.out(); e.xin_c = (const float*)(ws + WS_XC); e.xout_l = P.out(); e.xout_c = (float*)(ws + WS_XC); e.gate = MOD + 5 * MODW + 10240;
        break;
    }
}

namespace pg8 { __device__ __forceinline__ void make_epi(const EpiSrc& es, Epi& E) { const KP P = kargs(); Gemm g; setup_gemm(P, es.ph, es.gi, g, E); } }
__global__ void __launch_bounds__(512) fwd_megakernel(Params Punused) {
    extern __shared__ __attribute__((aligned(16))) unsigned char lds_raw[];
    cg::grid_group grid = cg::this_grid();
    LAS unsigned char* lds = (LAS unsigned char*)lds_raw;
    volatile LAS unsigned* bst = (volatile LAS unsigned*)(lds + 131072 + 64);
    if (threadIdx.x < 2) bst[threadIdx.x] = 0u;
    __syncthreads();
    if (blockIdx.x == 0) { const KP P0 = kargs(); unsigned* bw = (unsigned*)(P0.ws() + WS_BAR); for (int i = threadIdx.x; i < XCD_BAR_WORDS; i += 512) __hip_atomic_store(bw + i, 0u, __ATOMIC_RELAXED, __HIP_MEMORY_SCOPE_AGENT); }
#ifndef EN_MASK
#define EN_MASK 0xffffffffu
#endif
#define EN(k) (((EN_MASK) >> (k)) & 1u)
#ifndef DUP_MASK
#define DUP_MASK 0u
#endif
#ifndef XSYNC
#define XSYNC 0
#endif
#pragma unroll 1
    for (int ph2 = 0; ph2 < 46; ++ph2) {
        const int ph = ph2 >> 1;
        if ((ph2 & 1) && !(((unsigned)(DUP_MASK) >> ph) & 1u)) continue;
        int tid = threadIdx.x; asm volatile("" : "+v"(tid));
        int bx = blockIdx.x, G = gridDim.x; asm volatile("" : "+s"(bx), "+s"(G));
#define lane (tid & 63)
#define wave (__builtin_amdgcn_readfirstlane(tid >> 6))
#define gw (bx * 8 + wave)
#define ngw (G * 8)
#define gtid (bx * 512 + tid)
#define ngt (G * 512)
        const KP P = kargs();
        unsigned char* ws = P.ws();
        bf16_t* W = (bf16_t*)(ws + WS_W);
        const float* MOD = (const float*)(ws + WS_MOD);
        switch (ph) {
        case 0: if (EN(0)) {
            adaln_tasks(P, lds, tid, bx, G);
            __syncthreads();
            LAS float* scr = (LAS float*)(lds + wave * 16384);
            constexpr int NIT = 4 * 2048 + 4 * 96 + 256 + 256 + 11264 + 5632;
            for (int it = gw; it < NIT; it += ngw) {
                int r = it;
                TR(P.in(9), D, D, W + W_RKV / 2, D, 0)
                TR(P.in(10), D, D, W + W_RKV / 2 + (size_t)D * D, D, 0)
                TR(P.in(11), D, D, W + W_RKV / 2 + 2 * (size_t)D * D, D, 0)
                TR(P.in(12), D, D, W + W_RWO / 2, D, 0)
                TR(P.in(14), D, 96, W + W_L1 / 2, D, 0)
                TR(P.in(14) + D * 96, D, 96, W + W_L1 / 2, D, 96)
                TR(P.in(17), D, 96, W + W_L1 / 2 + 256 * D, D, 0)
                TR(P.in(17) + D * 96, D, 96, W + W_L1 / 2 + 256 * D, D, 96)
                TR(P.in(19), D, 256, W + W_L1 / 2 + 2 * 256 * D, D, 0)
                TR(P.in(20), 256, D, W + W_G2 / 2, 256, 0)
                TRI(P.in(32), D, 2 * DFF, W + W_UP / 2, D)
                TR(P.in(35), DFF, D, W + W_DN / 2, DFF, 0)
            }
            for (int idx = gtid; idx < 4 * D * 256; idx += ngt) {
                const int z = idx >> 19, n = (idx >> 8) & 2047, kk = idx & 255, d = z & 1;
                const float* src = z < 2 ? P.in(15) : P.in(18);
                float val = 0.f; if (kk >= 96 * d && kk < 96 * d + 96) val = src[((size_t)d * 96 + (kk - 96 * d)) * D + n];
                W[W_L2 / 2 + idx] = (bf16_t)(cvt_pk_bf16(val, val) & 0xffffu);
            }
            for (int idx = gtid; idx < 2 * 64 * D; idx += ngt) { const int z = idx / (64 * D), rem = idx % (64 * D); W[W_L1 / 2 + (size_t)z * 256 * D + 192 * D + rem] = 0; }
        } break;
        case 1: if (EN(1)) mix_phase(P, gw, ngw, lane); break;
        case 4: if (EN(4)) scan_phase(P, lds, tid, bx, G); break;
        case 6: if (EN(6)) readout_phase(P, gw, ngw, lane); break;
        case 8: if (EN(8)) modnorm_phase(P.out(), (const float*)(ws + WS_XC), P.in(6) + D, MOD, 6144, 8192, (bf16_t*)(ws + WS_KV), T, gw, ngw, lane); break;
        case 10: if (EN(10)) fixup_phase((const bf16_t*)(ws + WS_BIG), (const bf16_t*)(ws + WS_BIG + 16 * MiB), (bf16_t*)(ws + WS_GF), P.in(33), P.in(34), T, gtid, ngt); break;
        case 12: if (EN(12)) {
            modnorm_phase(P.out(), (const float*)(ws + WS_XC), P.in(6) + 2 * D, MOD + 5 * MODW, 0, 2048, (bf16_t*)(ws + WS_BIG), T, gw, ngw, lane);
            LAS float* scr = (LAS float*)(lds + wave * 16384);
            constexpr int NIT = 32 * 34 + 8 * 96 + 8 * 128 + 2048 + 11264 + 5632;
            for (int it = gw; it < NIT; it += ngw) {
                int r = it;
                TR(P.in(26), D, 1088, W + W_MLD / 2, D, 0)
                TR(P.in(29), 512, 3072, W + W_UQ / 2, 512, 0)
                TR(P.in(30), 512, 4096, W + W_UKV / 2, 512, 0)
                TR(P.in(31), D, D, W + W_MLO / 2, D, 0)
                TRI(P.in(32) + (size_t)D * 2 * DFF, D, 2 * DFF, W + W_UP / 2, D)
                TR(P.in(35) + (size_t)DFF * D, DFF, D, W + W_DN / 2, DFF, 0)
            }
            for (int idx = gtid; idx < 192 * D; idx += ngt) W[W_MLD / 2 + (size_t)1088 * D + idx] = 0;
        } break;
        case 14: if (EN(14)) mla_mid_phase(P, gw, ngw, lane); break;
        case 16: if (EN(16)) {
            const int vcu = (G % 8 == 0) ? (bx % 8) * (G / 8) + bx / 8 : bx;
            for (int u = vcu; u < 1024; u += G) {
                const int bh = u >> 4, qb = u & 15;
                att::attn_unit((const bf16_t*)(ws + WS_BIG + 190 * MiB), (const bf16_t*)(ws + WS_KV), (const bf16_t*)(ws + WS_BIG + 187 * MiB), (bf16_t*)(ws + WS_BIG), bh >> 4, bh & 15, qb, (char*)lds_raw, tid);
            }
        } break;
        case 18: if (EN(18)) modnorm_phase(P.out(), (const float*)(ws + WS_XC), P.in(6) + 3 * D, MOD + 5 * MODW, 6144, 8192, (bf16_t*)(ws + WS_KV), NL, gw, ngw, lane); break;
        case 20: if (EN(20)) fixup_phase((const bf16_t*)(ws + WS_BIG), (const bf16_t*)(ws + WS_BIG + 16 * MiB), (bf16_t*)(ws + WS_GF), P.in(33) + 3 * DFF, P.in(34) + DFF, NL, gtid, ngt); break;
        case 22: if (EN(22)) {
            const float* fg = P.in(7);
            for (int r0 = 4 * gw; r0 < NL; r0 += 4 * ngw) {
                float* xr = P.out() + (size_t)r0 * D;
                f32x4 x[4][8]; float ss[4];
#pragma unroll
                for (int i = 0; i < 4; ++i) {
                    float sq = 0.f;
#pragma unroll
                    for (int j = 0; j < 8; ++j) { x[i][j] = *(const f32x4*)(xr + (size_t)i * D + 4 * lane + 256 * j); sq += (x[i][j].x * x[i][j].x + x[i][j].y * x[i][j].y) + (x[i][j].z * x[i][j].z + x[i][j].w * x[i][j].w); }
                    ss[i] = sq;
                }
#pragma unroll
                for (int o = 1; o < 64; o <<= 1) {
#pragma unroll
                    for (int i = 0; i < 4; ++i) ss[i] += __shfl_xor(ss[i], o);
                }
#pragma unroll
                for (int j = 0; j < 8; ++j) {
                    const int col = 4 * lane + 256 * j; const f32x4 gg = *(const f32x4*)(fg + col);
#pragma unroll
                    for (int i = 0; i < 4; ++i) *(f32x4*)(xr + (size_t)i * D + col) = x[i][j] * rsqrtf(ss[i] * (1.0f / D) + 1e-6f) * gg;
                }
            }
        } break;
        default: if (EN(2)) {
            const int ng = (ph == 2 || ph == 3 || ph == 15) ? 2 : 1;
#pragma unroll 1
            for (int gi = 0; gi < ng; ++gi) {
                pg8::Gemm g; pg8::Epi e; setup_gemm(P, ph, gi, g, e);
                pg8::StaticOrder S; S.init(g.M, g.N, g.nz, G, bx);
                pg8::EpiSrc es; es.ph = ph; es.gi = gi;
                pg8::gemm_phase(lds, g, S, es, e.perm | (e.mode == 4 ? 2 : 0), tid);
            }
        } break;
        }
        if (ph == 0) {
            grid.sync();
            if (threadIdx.x == 0) { const KP P1 = kargs(); (void)xb_add((unsigned*)(P1.ws() + WS_BAR) + XB_XCNT(xb_xcc_id()), 1u); }
        } else { XcdBarrier xb2; { const KP P1 = kargs(); xb2.bar = (unsigned*)(P1.ws() + WS_BAR); } xb2.x = xb_xcc_id(); xb2.st = (volatile LAS unsigned*)(lds + 131072 + 64); xcd_barrier(xb2); }
    }
}

#undef lane
#undef wave
#undef gw
#undef ngw
#undef gtid
#undef ngt
extern "C" void kernel_launch(void* const* d_in, const int* in_sizes, int n_in, void* d_out, int out_size, void* d_ws, size_t ws_size, hipStream_t stream) {
    static int grid = 0;
    if (grid == 0) {
        if (n_in != 36 || out_size != NL * D || ws_size < WS_END) { fprintf(stderr, "kernel_launch: unexpected shapes (n_in %d out %d ws %zu)\n", n_in, out_size, ws_size); grid = -1; return; }
        int dev = 0, cus = 0, per_cu = 0;
        hipGetDevice(&dev);
        hipDeviceGetAttribute(&cus, hipDeviceAttributeMultiprocessorCount, dev);
        hipFuncSetAttribute((const void*)fwd_megakernel, hipFuncAttributeMaxDynamicSharedMemorySize, LDS_BYTES);
        hipOccupancyMaxActiveBlocksPerMultiprocessor(&per_cu, (const void*)fwd_megakernel, 512, LDS_BYTES);
        if (per_cu < 1) per_cu = 1;
        grid = cus * per_cu;
        if (grid > 256) grid = 256;
    }
    if (grid < 0) return;
    Params p{};
    for (int i = 0; i < 36; ++i) p.in[i] = (const float*)d_in[i];
    p.out = (float*)d_out; p.ws = (unsigned char*)d_ws;
    void* args[] = {&p};
    hipError_t e = hipLaunchCooperativeKernel((const void*)fwd_megakernel, dim3(grid), dim3(512), args, LDS_BYTES, stream);
    if (e != hipSuccess) fprintf(stderr, "cooperative launch failed: %s (grid %d)\n", hipGetErrorString(e), grid);
}
```

```cpp
#include <hip/hip_runtime.h>
#include <hip/hip_cooperative_groups.h>
#include <cstdio>
#include <cstdint>
namespace cg = cooperative_groups;

#define LAS __attribute__((address_space(3)))
typedef unsigned short bf16_t;
typedef short bf16x8 __attribute__((ext_vector_type(8)));
typedef short s16x4 __attribute__((ext_vector_type(4)));
typedef float f32x4 __attribute__((ext_vector_type(4)));
typedef float f32x2 __attribute__((ext_vector_type(2)));
typedef float f32x16 __attribute__((ext_vector_type(16)));
typedef unsigned u32x4 __attribute__((ext_vector_type(4)));
typedef unsigned u32x2 __attribute__((ext_vector_type(2)));

constexpr int D = 2048, NL = 16384, NC = 1024, T = NL + NC, SEQ = 4096, CTXL = 256, DFF = 5632, MODW = 12288;
constexpr size_t MiB = 1u << 20;
constexpr size_t WS_MOD = 0;
constexpr size_t WS_BAR = 512 * 1024;
constexpr size_t WS_XC = 1 * MiB;
constexpr size_t WS_W = 9 * MiB;
constexpr size_t WS_BIG = 115 * MiB;
constexpr size_t WS_KV = 523 * MiB;
constexpr size_t WS_GF = WS_BIG + 32 * MiB;
constexpr size_t WS_BON = 676 * MiB;
constexpr size_t WS_END = 681 * MiB;
constexpr size_t W_RKV = 0, W_RWO = 24 * MiB, W_L1 = 32 * MiB, W_L2 = 35 * MiB, W_G2 = 39 * MiB, W_UP = 40 * MiB, W_DN = 84 * MiB;
constexpr size_t W_MLD = 0, W_UQ = 5 * MiB, W_UKV = 8 * MiB, W_MLO = 12 * MiB;
constexpr size_t S68 = 68 * MiB;
constexpr int LDS_BYTES = 147456;

struct Params { const float* in[36]; float* out; unsigned char* ws; };
typedef const __attribute__((address_space(4))) unsigned char* kptr_t;
struct KP {
    kptr_t p;
    __device__ __forceinline__ const float* in(int i) const { return *(const float* const __attribute__((address_space(4)))*)(p + 8 * i); }
    __device__ __forceinline__ float* out() const { return *(float* const __attribute__((address_space(4)))*)(p + 288); }
    __device__ __forceinline__ unsigned char* ws() const { return *(unsigned char* const __attribute__((address_space(4)))*)(p + 296); }
};
__device__ __forceinline__ KP kargs() { kptr_t p = (kptr_t)__builtin_amdgcn_kernarg_segment_ptr(); asm volatile("" : "+s"(p)); KP k; k.p = p; return k; }

typedef __bf16 bf16x2_t __attribute__((ext_vector_type(2)));
__device__ __forceinline__ unsigned cvt_pk_bf16(float lo, float hi) { const f32x2 v = {lo, hi}; const bf16x2_t b = __builtin_convertvector(v, bf16x2_t); return __builtin_bit_cast(unsigned, b); }
__device__ __forceinline__ unsigned cvt_pk_f16(float lo, float hi) { _Float16 a = (_Float16)lo, b = (_Float16)hi; return (unsigned)__builtin_bit_cast(unsigned short, a) | ((unsigned)__builtin_bit_cast(unsigned short, b) << 16); }
__device__ __forceinline__ float bf_lo(unsigned w) { return __uint_as_float(w << 16); }
__device__ __forceinline__ float bf_hi(unsigned w) { return __uint_as_float(w & 0xffff0000u); }
__device__ __forceinline__ float h_lo(unsigned w) { return (float)__builtin_bit_cast(_Float16, (unsigned short)(w & 0xffffu)); }
__device__ __forceinline__ float h_hi(unsigned w) { return (float)__builtin_bit_cast(_Float16, (unsigned short)(w >> 16)); }
__device__ __forceinline__ float sigmoidf_(float x) { return __builtin_amdgcn_rcpf(1.0f + __expf(-x)); }
__device__ __forceinline__ float tanhf_(float x) { const float e = __expf(2.0f * x); return 1.0f - 2.0f * __builtin_amdgcn_rcpf(e + 1.0f); }
__device__ __forceinline__ float wave_sum(float v) {
#pragma unroll
    for (int o = 1; o < 64; o <<= 1) v += __shfl_xor(v, o);
    return v;
}
template <int CTRL> __device__ __forceinline__ float dpp_mov(float x) { return __int_as_float(__builtin_amdgcn_update_dpp(0, __float_as_int(x), CTRL, 0xF, 0xF, true)); }
__device__ __forceinline__ float red8(float x) { x += dpp_mov<0xB1>(x); x += dpp_mov<0x4E>(x); x += dpp_mov<0x141>(x); return x; }
__device__ __forceinline__ float red16(float x) { x += dpp_mov<0xB1>(x); x += dpp_mov<0x4E>(x); x += dpp_mov<0x141>(x); x += dpp_mov<0x140>(x); return x; }

namespace pg8 {
constexpr int BM = 256, BK = 64, HALF = 128, HTB = HALF * BK * 2, STAGE_BYTES = 8 * HTB, NXCD = 8, WGM = 8;
__device__ __forceinline__ int lds_byte(int r, int c) { const int st = (r >> 4) * 2 + (c >> 5), rr = r & 15, cc = c & 31, ob = rr * 64 + cc * 2; return st * 1024 + (ob ^ (((ob >> 9) & 1) << 5)); }
__device__ __forceinline__ void stage_rc(int b, int& R, int& C) { const int st = b / 1024, sb = b % 1024, swz = sb ^ (((sb >> 9) & 1) << 5); R = (st >> 1) * 16 + swz / 64; C = (st & 1) * 32 + (swz % 64) / 2; }
__device__ __forceinline__ int perm32(int rho) { const int n = rho >> 4, i = rho & 15; return 8 * (i >> 2) + 4 * n + (i & 3); }

struct Unit { int pm, pn, z; };
struct Gemm { const bf16_t* A; const bf16_t* Bt; int lda, ldb; int sAz, sBz; int M, N, K, nz; };
struct StaticOrder {
    int nM, nN, nwg, G, c, tot;
    __device__ void init(int M, int N, int nz, int G_, int c_) { nM = M / BM; nN = N / BM; nwg = nM * nN; G = G_; c = c_; tot = nwg * nz; }
    __device__ bool next(int i, Unit& u) const {
        const long L = (long)i * G + c; if (L >= tot) return false;
        u.z = (int)(L / nwg);
        int wgid = (int)(L % nwg); { const int q = nwg / NXCD, r = nwg % NXCD, xcd = wgid % NXCD, off = wgid / NXCD; wgid = (xcd < r ? xcd * (q + 1) : r * (q + 1) + (xcd - r) * q) + off; }
        const int nig = WGM * nN, gid = wgid / nig, fm = gid * WGM, gsz = (nM - fm) < WGM ? (nM - fm) : WGM;
        u.pm = fm + ((wgid % nig) % gsz); u.pn = (wgid % nig) / gsz; return true;
    }
};

struct Epi {
    int mode;
    int perm;
    int acts;
    int ldc; long sCz;
    union { void* o0; const float* xin_l; };
    union { void* o1; const float* xin_c; };
    union { void* o2; float* xout_l; };
    union { const float* b0; float* xout_c; };
    union { const float* b1; const float* gate; };
};
__device__ __forceinline__ void epilogue(const Epi& E, const f32x4 (&acc)[2][2][4][2], const Unit& u, int wr, int wc, int fr, int fq) {
    if (E.mode == 4) {
        bf16_t* Gf = (bf16_t*)E.o0; bf16_t* RAW = (bf16_t*)E.o1; bf16_t* VAL = (bf16_t*)E.o2;
        const int ch0 = u.pn * HALF + wc * 32 + 8 * fq;
        f32x4 cw0[2], cw1[2], cw2[2], cbb[2];
#pragma unroll
        for (int n = 0; n < 2; ++n) { cw0[n] = *(const f32x4*)(E.b0 + ch0 + 4 * n); cw1[n] = *(const f32x4*)(E.b0 + DFF + ch0 + 4 * n); cw2[n] = *(const f32x4*)(E.b0 + 2 * DFF + ch0 + 4 * n); cbb[n] = *(const f32x4*)(E.b1 + ch0 + 4 * n); }
#pragma unroll
        for (int ai = 0; ai < 2; ++ai) {
            const int rowb = u.pm * BM + ai * HALF + wr * 64, blk = rowb >> 6;
#pragma unroll
            for (int m = 0; m < 4; ++m) {
                float o[8];
#pragma unroll
                for (int n = 0; n < 2; ++n) {
                    const f32x4 c0 = cw0[n], c1 = cw1[n], c2 = cw2[n], cbv = cbb[n];
#pragma unroll
                    for (int e = 0; e < 4; ++e) {
                        const float gc = acc[ai][0][m][n][e];
                        const float gp = m > 0 ? acc[ai][0][m > 0 ? m - 1 : 0][n][e] : dpp_mov<0x121>(acc[ai][0][3][n][e]);
                        const float gn = m < 3 ? acc[ai][0][m < 3 ? m + 1 : 3][n][e] : dpp_mov<0x12F>(acc[ai][0][0][n][e]);
                        const float gt = gp * c0[e] + gc * c1[e] + gn * c2[e] + cbv[e];
                        o[4 * n + e] = gt * __builtin_amdgcn_rcpf(1.0f + __expf(-gt)) * acc[ai][1][m][n][e];
                    }
                }
                u32x4 w; w.x = cvt_pk_bf16(o[0], o[1]); w.y = cvt_pk_bf16(o[2], o[3]); w.z = cvt_pk_bf16(o[4], o[5]); w.w = cvt_pk_bf16(o[6], o[7]);
                *(u32x4*)(Gf + (size_t)(rowb + 4 * fr + m) * DFF + ch0) = w;
                {
                    const int br = 4 * fr + m;
                    const int slot = br == 0 ? 0 : br == 1 ? 1 : br == 62 ? 2 : br == 63 ? 3 : -1;
                    if (slot >= 0) {
                        u32x4 g; g.x = cvt_pk_bf16(acc[ai][0][m][0][0], acc[ai][0][m][0][1]); g.y = cvt_pk_bf16(acc[ai][0][m][0][2], acc[ai][0][m][0][3]);
                        g.z = cvt_pk_bf16(acc[ai][0][m][1][0], acc[ai][0][m][1][1]); g.w = cvt_pk_bf16(acc[ai][0][m][1][2], acc[ai][0][m][1][3]);
                        *(u32x4*)(RAW + ((size_t)blk * 4 + slot) * DFF + ch0) = g;
                        if (slot == 0 || slot == 3) {
                            u32x4 vv; vv.x = cvt_pk_bf16(acc[ai][1][m][0][0], acc[ai][1][m][0][1]); vv.y = cvt_pk_bf16(acc[ai][1][m][0][2], acc[ai][1][m][0][3]);
                            vv.z = cvt_pk_bf16(acc[ai][1][m][1][0], acc[ai][1][m][1][1]); vv.w = cvt_pk_bf16(acc[ai][1][m][1][2], acc[ai][1][m][1][3]);
                            *(u32x4*)(VAL + ((size_t)blk * 2 + (slot ? 1 : 0)) * DFF + ch0) = vv;
                        }
                    }
                }
                asm volatile("" ::: "memory");
            }
        }
        return;
    }
    if (E.mode <= 1) {
        unsigned short* base = (u.z == 1 && E.o1) ? (unsigned short*)E.o1 : (u.z == 2 && E.o2) ? (unsigned short*)E.o2 : (unsigned short*)E.o0 + (size_t)u.z * E.sCz;
        const int row0 = u.pm * BM + wr * 64 + fr, col0 = u.pn * BM + wc * 32 + 8 * fq;
        const int act = E.mode == 0 ? ((E.acts >> (4 * u.z)) & 15) : 0;
        f32x4 bv[2][2];
#pragma unroll
        for (int bj = 0; bj < 2; ++bj)
#pragma unroll
            for (int n = 0; n < 2; ++n) bv[bj][n] = (f32x4){0.f, 0.f, 0.f, 0.f};
        if (E.mode == 1) {
            const int zz = u.z + E.acts;
            const float* bp = (zz < 2 ? E.b0 + zz * D : E.b1 + (zz - 2) * D) + col0;
#pragma unroll
            for (int bj = 0; bj < 2; ++bj)
#pragma unroll
                for (int n = 0; n < 2; ++n) bv[bj][n] = *(const f32x4*)(bp + bj * HALF + 4 * n);
        }
#pragma unroll
        for (int ai = 0; ai < 2; ++ai)
#pragma unroll
            for (int m = 0; m < 4; ++m) {
                unsigned short* rowp = base + (size_t)(row0 + ai * HALF + m * 16) * E.ldc + col0;
#pragma unroll
                for (int bj = 0; bj < 2; ++bj) {
                    f32x4 v0 = acc[ai][bj][m][0] + bv[bj][0], v1 = acc[ai][bj][m][1] + bv[bj][1];
                    u32x4 w;
                    if (E.mode == 0) {
                        if (act == 1) {
#pragma unroll
                            for (int e = 0; e < 4; ++e) { v0[e] = tanhf_(v0[e]); v1[e] = tanhf_(v1[e]); }
                        } else if (act == 2) {
#pragma unroll
                            for (int e = 0; e < 4; ++e) { v0[e] = sigmoidf_(v0[e]); v1[e] = sigmoidf_(v1[e]); }
                        }
                        w.x = cvt_pk_bf16(v0[0], v0[1]); w.y = cvt_pk_bf16(v0[2], v0[3]); w.z = cvt_pk_bf16(v1[0], v1[1]); w.w = cvt_pk_bf16(v1[2], v1[3]);
                    } else {
                        const float sc = (u.z + E.acts < 2) ? 0.6065306597126334f : 1.0f;
#pragma unroll
                        for (int e = 0; e < 4; ++e) {
                            v0[e] = sc * __builtin_amdgcn_rcpf(1.0f + __builtin_amdgcn_exp2f(fmaf(acc[ai][bj][m][0][e], -1.4426950408889634f, -1.4426950408889634f * bv[bj][0][e])));
                            v1[e] = sc * __builtin_amdgcn_rcpf(1.0f + __builtin_amdgcn_exp2f(fmaf(acc[ai][bj][m][1][e], -1.4426950408889634f, -1.4426950408889634f * bv[bj][1][e])));
                        }
                        w.x = cvt_pk_f16(v0[0], v0[1]); w.y = cvt_pk_f16(v0[2], v0[3]); w.z = cvt_pk_f16(v1[0], v1[1]); w.w = cvt_pk_f16(v1[2], v1[3]);
                    }
                    *(u32x4*)(rowp + bj * HALF) = w;
                }
                asm volatile("" ::: "memory");
            }
    } else {
        const int col0 = u.pn * BM + wc * 32 + 4 * fq;
        const int rowt = u.pm * BM;
        if (E.mode == 2) {
            float* base = (float*)E.o0;
#pragma unroll
            for (int ai = 0; ai < 2; ++ai)
#pragma unroll
                for (int m = 0; m < 4; ++m) {
                    float* rowp = base + (size_t)(rowt + ai * HALF + wr * 64 + m * 16 + fr) * E.ldc + col0;
#pragma unroll
                    for (int bj = 0; bj < 2; ++bj)
#pragma unroll
                        for (int n = 0; n < 2; ++n) *(f32x4*)(rowp + bj * HALF + n * 16) = acc[ai][bj][m][n];
                    asm volatile("" ::: "memory");
                }
        } else {
            const bool lat = rowt < NL;
            const int v = lat ? (rowt >> 12) : 4;
            const float* xin = lat ? E.xin_l + (size_t)rowt * D : E.xin_c + (size_t)(rowt - NL) * D;
            float* xout = lat ? E.xout_l + (size_t)rowt * D : E.xout_c + (size_t)(rowt - NL) * D;
            const float* gp = E.gate + (size_t)v * MODW + col0;
            f32x4 gv[2][2];
#pragma unroll
            for (int bj = 0; bj < 2; ++bj)
#pragma unroll
                for (int n = 0; n < 2; ++n) gv[bj][n] = *(const f32x4*)(gp + bj * HALF + n * 16);
#pragma unroll
            for (int ai = 0; ai < 2; ++ai)
#pragma unroll
                for (int mp = 0; mp < 4; mp += 2) {
                    f32x4 xi[2][2][2];
#pragma unroll
                    for (int m = 0; m < 2; ++m) {
                        const size_t off = (size_t)(ai * HALF + wr * 64 + (mp + m) * 16 + fr) * D + col0;
#pragma unroll
                        for (int bj = 0; bj < 2; ++bj)
#pragma unroll
                            for (int n = 0; n < 2; ++n) xi[m][bj][n] = *(const f32x4*)(xin + off + bj * HALF + n * 16);
                    }
                    asm volatile("" ::: "memory");
#pragma unroll
                    for (int m = 0; m < 2; ++m) {
                        const size_t off = (size_t)(ai * HALF + wr * 64 + (mp + m) * 16 + fr) * D + col0;
#pragma unroll
                        for (int bj = 0; bj < 2; ++bj)
#pragma unroll
                            for (int n = 0; n < 2; ++n) *(f32x4*)(xout + off + bj * HALF + n * 16) = xi[m][bj][n] + gv[bj][n] * acc[ai][bj][mp + m][n];
                    }
                    asm volatile("" ::: "memory");
                }
        }
    }
}

struct EpiSrc { int ph, gi; };
__device__ __forceinline__ void make_epi(const EpiSrc& es, Epi& E);
__device__ __forceinline__ void gemm_phase(LAS unsigned char* lds, const Gemm g, const StaticOrder& S, const EpiSrc es, const int perm, const int tid) {
    const int wid = __builtin_amdgcn_readfirstlane(tid >> 6), lane = tid & 63, wr = wid >> 2, wc = wid & 3, fr = lane & 15, fq = lane >> 4;
    const int K = g.K, nt = K / BK;
    unsigned voffA, voffB;
    { int R, C; stage_rc(tid * 16, R, C); const int Rb = (perm & 1) ? ((R & ~31) + perm32(R & 31)) : R;
        const int Ra = (perm & 2) ? ((R & ~63) + 4 * (R & 15) + ((R >> 4) & 3)) : R;
        voffA = (unsigned)(Ra * g.lda + C) * 2u; voffB = (unsigned)(Rb * g.ldb + C) * 2u; }
    const unsigned kstep = BK * 2;
    const unsigned hstepA = (unsigned)HALF * g.lda * 2, hstepB = (unsigned)HALF * g.ldb * 2;
    const unsigned tstepA = 2 * hstepA, tstepB = 2 * hstepB;
    const unsigned r64voffA = hstepA >> 1, r64voffB = hstepB >> 1; const unsigned voffA_ = voffA, voffB_ = voffB;
    const unsigned ldsw = (unsigned)wid * 1024u;
    const int aoff = lds_byte(wr * 64 + fr, fq * 8), boff = lds_byte(wc * 32 + fr, fq * 8);
#define PG8_SA(b, h) (((b) * 2 + (h)) * HTB)
#define PG8_SB(b, h) ((4 + (b) * 2 + (h)) * HTB)
#define PG8_STAGE(bufoff, gbase, voff) do { _Pragma("unroll") for (int _i = 0; _i < 2; ++_i) \
        __builtin_amdgcn_global_load_lds((const unsigned*)((const char*)(gbase) + _i * r64##voff + voff##_), (LAS unsigned*)(lds + (bufoff) + ldsw + _i * 8192), 16, 0, 0); } while (0)
#define PG8_LDA(dst, b, h) do { _Pragma("unroll") for (int m = 0; m < 4; ++m) _Pragma("unroll") for (int k = 0; k < 2; ++k) dst[m][k] = *(const LAS bf16x8*)(lds + PG8_SA(b, h) + aoff + m * 2048 + k * 1024); } while (0)
#define PG8_LDB(dst, b, h) do { _Pragma("unroll") for (int n = 0; n < 2; ++n) _Pragma("unroll") for (int k = 0; k < 2; ++k) dst[n][k] = *(const LAS bf16x8*)(lds + PG8_SB(b, h) + boff + n * 2048 + k * 1024); } while (0)
#define PG8_MMA(ai, bj, At, Bt) do { __builtin_amdgcn_s_setprio(1); _Pragma("unroll") for (int m = 0; m < 4; ++m) _Pragma("unroll") for (int n = 0; n < 2; ++n) _Pragma("unroll") for (int k = 0; k < 2; ++k) \
        acc[ai][bj][m][n] = __builtin_amdgcn_mfma_f32_16x16x32_bf16(Bt[n][k], At[m][k], acc[ai][bj][m][n], 0, 0, 0); __builtin_amdgcn_s_setprio(0); } while (0)
#define PG8_WAIT_V(n) asm volatile("s_waitcnt vmcnt(" #n ")" ::: "memory")
#define PG8_WAIT_L(n) asm volatile("s_waitcnt lgkmcnt(" #n ")" ::: "memory")
#define PG8_BAR __builtin_amdgcn_s_barrier()
#define PG8_SCHED __builtin_amdgcn_sched_barrier(0)
    Unit cur, nxt; int ui = 0;
    if (!S.next(0, cur)) return;
    f32x4 acc[2][2][4][2];
#pragma unroll
    for (int a = 0; a < 2; ++a)
#pragma unroll
        for (int b = 0; b < 2; ++b)
#pragma unroll
            for (int m = 0; m < 4; ++m)
#pragma unroll
                for (int n = 0; n < 2; ++n) acc[a][b][m][n] = (f32x4){0.f, 0.f, 0.f, 0.f};
    bf16x8 At[4][2], B0[2][2], B1[2][2];
    const char* cA = (const char*)g.A + (size_t)((unsigned)cur.z * (unsigned)g.sAz * 2u + (unsigned)cur.pm * tstepA); const char* cB = (const char*)g.Bt + (size_t)((unsigned)cur.z * (unsigned)g.sBz * 2u + (unsigned)cur.pn * tstepB);
    PG8_STAGE(PG8_SB(0, 0), cB, voffB); PG8_STAGE(PG8_SB(0, 1), cB + hstepB, voffB); PG8_STAGE(PG8_SA(0, 0), cA, voffA); PG8_STAGE(PG8_SA(0, 1), cA + hstepA, voffA);
    if (wr == 1) PG8_BAR;
    PG8_WAIT_V(2); PG8_BAR;
    PG8_STAGE(PG8_SB(1, 0), cB + kstep, voffB); PG8_STAGE(PG8_SA(1, 0), cA + kstep, voffA); PG8_STAGE(PG8_SB(1, 1), cB + hstepB + kstep, voffB);
    PG8_WAIT_V(6); PG8_BAR;
    for (;;) {
        const bool has_next = S.next(ui + 1, nxt);
        const char* nA = has_next ? (const char*)g.A + (size_t)((unsigned)nxt.z * (unsigned)g.sAz * 2u + (unsigned)nxt.pm * tstepA) : cA; const char* nB = has_next ? (const char*)g.Bt + (size_t)((unsigned)nxt.z * (unsigned)g.sBz * 2u + (unsigned)nxt.pn * tstepB) : cB;
        for (int t = 0; t < nt; t += 2) {
            const bool last = (t == nt - 2);
            const char* a1 = cA + (size_t)(t + 1) * kstep;
            const char* a2 = last ? nA : cA + (size_t)(t + 2) * kstep; const char* b2 = last ? nB : cB + (size_t)(t + 2) * kstep;
            const char* a3 = a2 + kstep; const char* b3 = b2 + kstep;
            PG8_LDB(B0, 0, 0); PG8_LDB(B1, 0, 1); PG8_SCHED; PG8_LDA(At, 0, 0); PG8_STAGE(PG8_SA(1, 1), a1 + hstepA, voffA);
            PG8_WAIT_V(8); PG8_WAIT_L(0); PG8_BAR; PG8_MMA(0, 0, At, B0); PG8_MMA(0, 1, At, B1); PG8_BAR; PG8_SCHED;
            PG8_LDA(At, 0, 1); PG8_STAGE(PG8_SB(0, 0), b2, voffB); PG8_STAGE(PG8_SB(0, 1), b2 + hstepB, voffB); PG8_STAGE(PG8_SA(0, 0), a2, voffA);
            PG8_WAIT_V(8); PG8_WAIT_L(0); PG8_BAR; PG8_MMA(1, 0, At, B0); PG8_MMA(1, 1, At, B1); PG8_BAR; PG8_SCHED;
            PG8_LDB(B0, 1, 0); PG8_LDB(B1, 1, 1); PG8_SCHED; PG8_LDA(At, 1, 0); PG8_STAGE(PG8_SA(0, 1), a2 + hstepA, voffA);
            PG8_WAIT_V(8); PG8_WAIT_L(0); PG8_BAR; PG8_MMA(0, 0, At, B0); PG8_MMA(0, 1, At, B1); PG8_BAR; PG8_SCHED;
            PG8_LDA(At, 1, 1); PG8_STAGE(PG8_SB(1, 0), b3, voffB); PG8_STAGE(PG8_SB(1, 1), b3 + hstepB, voffB); PG8_STAGE(PG8_SA(1, 0), a3, voffA);
            PG8_WAIT_V(8); PG8_WAIT_L(0); PG8_BAR; PG8_MMA(1, 0, At, B0); PG8_MMA(1, 1, At, B1); PG8_BAR; PG8_SCHED;
        }
        if (wr == 0) PG8_BAR;
        { Epi E; make_epi(es, E); epilogue(E, acc, cur, wr, wc, fr, fq); }
        if (!has_next) break;
#pragma unroll
        for (int a = 0; a < 2; ++a)
#pragma unroll
            for (int b = 0; b < 2; ++b)
#pragma unroll
                for (int m = 0; m < 4; ++m)
#pragma unroll
                    for (int n = 0; n < 2; ++n) acc[a][b][m][n] = (f32x4){0.f, 0.f, 0.f, 0.f};
        cur = nxt; cA = nA; cB = nB; ++ui;
        if (wr == 1) PG8_BAR;
    }
    PG8_WAIT_V(0);
    PG8_BAR;
#undef PG8_SA
#undef PG8_SB
#undef PG8_STAGE
#undef PG8_LDA
#undef PG8_LDB
#undef PG8_MMA
#undef PG8_WAIT_V
#undef PG8_WAIT_L
#undef PG8_BAR
#undef PG8_SCHED
}
}

__device__ __forceinline__ void transpose_item(const float* W, int K, int N, bf16_t* WT, int ldo, int row_off, LAS float* scr, int item, int lane, int ilv = 0) {
    const int nblk = N / 32, kb = item / nblk, nb = item % nblk, k0 = 64 * kb, n0 = 32 * nb;
    float tv[32];
    const float* wp = W + (size_t)(k0 + (lane >> 5)) * N + n0 + (lane & 31);
#pragma unroll
    for (int i = 0; i < 32; ++i) tv[i] = wp[(size_t)(2 * i) * N];
#pragma unroll
    for (int i = 0; i < 32; ++i) scr[(2 * i + (lane >> 5)) * 33 + (lane & 31)] = tv[i];
    asm volatile("s_waitcnt lgkmcnt(0)" ::: "memory");
    const int c = lane & 7;
#pragma unroll
    for (int j = 0; j < 4; ++j) { const int n = (lane >> 3) + 8 * j; const LAS float* s = scr + (8 * c) * 33 + n;
        u32x4 o; o.x = cvt_pk_bf16(s[0 * 33], s[1 * 33]); o.y = cvt_pk_bf16(s[2 * 33], s[3 * 33]); o.z = cvt_pk_bf16(s[4 * 33], s[5 * 33]); o.w = cvt_pk_bf16(s[6 * 33], s[7 * 33]);
        const int nn = n0 + n; const int orow = ilv ? (nn >= DFF ? (((nn - DFF) >> 7) * 256 + 128 + ((nn - DFF) & 127)) : ((nn >> 7) * 256 + (nn & 127))) : row_off + nn;
        *(u32x4*)(WT + (size_t)orow * ldo + k0 + 8 * c) = o; }
    asm volatile("s_waitcnt lgkmcnt(0)" ::: "memory");
}
#define TR(src, K_, N_, dst, ldo, roff) { const int items_ = ((K_) / 64) * ((N_) / 32); if (r < items_) { transpose_item((src), (K_), (N_), (dst), (ldo), (roff), scr, r, lane); continue; } r -= items_; }
#define TRI(src, K_, N_, dst, ldo) { const int items_ = ((K_) / 64) * ((N_) / 32); if (r < items_) { transpose_item((src), (K_), (N_), (dst), (ldo), 0, scr, r, lane, 1); continue; } r -= items_; }

__device__ __forceinline__ void adaln_tasks(const KP& P, LAS unsigned char* lds, const int tid, const int bx, const int G) {
    if (bx >= 192) return;
    LAS float* sv = (LAS float*)lds;
    LAS float* red = (LAS float*)(lds + 40960);
    for (int i = tid; i < 5 * D; i += 512) { const int v = i >> 11, k = i & 2047; const float x = v < 4 ? P.in(1)[v * D + k] : P.in(3)[k]; sv[i] = x * __builtin_amdgcn_rcpf(1.0f + __expf(-x)); }
    __syncthreads();
    float* MOD = (float*)(P.ws() + WS_MOD);
    for (int task = bx; task < 192; task += G) {
        const int li = task / 96, cb = task % 96, cg = tid & 31, ks = tid >> 5;
        const float* wp = P.in(4) + (size_t)li * D * MODW + (size_t)(ks * 128) * MODW + cb * 128 + cg * 4;
        f32x4 a0 = {0, 0, 0, 0}, a1 = a0, a2 = a0, a3 = a0, a4 = a0;
#pragma unroll 16
        for (int k = 0; k < 128; ++k) {
            const f32x4 w = *(const f32x4*)(wp + (size_t)k * MODW);
            const int kk = ks * 128 + k;
            a0 += w * sv[kk]; a1 += w * sv[D + kk]; a2 += w * sv[2 * D + kk]; a3 += w * sv[3 * D + kk]; a4 += w * sv[4 * D + kk];
        }
        LAS f32x4* rp = (LAS f32x4*)(red + ks * 640 + cg * 4);
        rp[0] = a0; rp[32] = a1; rp[64] = a2; rp[96] = a3; rp[128] = a4;
        __syncthreads();
        for (int o = tid; o < 640; o += 512) {
            float s = 0.f;
#pragma unroll
            for (int q = 0; q < 16; ++q) s += red[q * 640 + o];
            const int v = o >> 7, cc = o & 127, col = cb * 128 + cc;
            MOD[((size_t)li * 5 + v) * MODW + col] = s + P.in(5)[li * MODW + col];
        }
        __syncthreads();
    }
}

__device__ __forceinline__ const float* xrow(const float* xl, const float* xc, int r) { return r < NL ? xl + (size_t)r * D : xc + (size_t)(r - NL) * D; }
__device__ __forceinline__ float row_rstd(const float* xr, int lane) {
    const f32x4* p = (const f32x4*)xr + lane; float s = 0.f;
#pragma unroll
    for (int j = 0; j < 8; ++j) { const f32x4 v = p[64 * j]; s += (v.x * v.x + v.y * v.y) + (v.z * v.z + v.w * v.w); }
    return rsqrtf(wave_sum(s) * (1.0f / D) + 1e-6f);
}
__device__ __forceinline__ void modnorm_phase(const float* xl, const float* xc, const float* g, const float* mod, int shift_off, int scale_off, bf16_t* out, int nrows, int gw, int ngw, int lane) {
    for (int r0 = 4 * gw; r0 < nrows; r0 += 4 * ngw) {
        const float* xr = xrow(xl, xc, r0); const int v = r0 < NL ? (r0 >> 12) : 4;
        f32x4 x[4][8]; float ss[4];
#pragma unroll
        for (int i = 0; i < 4; ++i) {
            float s = 0.f;
#pragma unroll
            for (int j = 0; j < 8; ++j) { x[i][j] = *(const f32x4*)(xr + (size_t)i * D + 4 * lane + 256 * j); s += (x[i][j].x * x[i][j].x + x[i][j].y * x[i][j].y) + (x[i][j].z * x[i][j].z + x[i][j].w * x[i][j].w); }
            ss[i] = s;
        }
#pragma unroll
        for (int o = 1; o < 64; o <<= 1) {
#pragma unroll
            for (int i = 0; i < 4; ++i) ss[i] += __shfl_xor(ss[i], o);
        }
        float rs[4];
#pragma unroll
        for (int i = 0; i < 4; ++i) rs[i] = rsqrtf(ss[i] * (1.0f / D) + 1e-6f);
        const float* mv = mod + (size_t)v * MODW;
#pragma unroll
        for (int j = 0; j < 8; ++j) {
            const int col = 4 * lane + 256 * j;
            const f32x4 gg = *(const f32x4*)(g + col), sc = *(const f32x4*)(mv + scale_off + col), sh = *(const f32x4*)(mv + shift_off + col);
            const f32x4 A = gg * (sc + 1.0f);
#pragma unroll
            for (int i = 0; i < 4; ++i) {
                const f32x4 h = x[i][j] * rs[i] * A + sh;
                u32x2 w; w.x = cvt_pk_bf16(h.x, h.y); w.y = cvt_pk_bf16(h.z, h.w);
                *(u32x2*)(out + (size_t)(r0 + i) * D + col) = w;
            }
        }
    }
}
__device__ __forceinline__ void mix_phase(const KP& P, int gw, int ngw, int lane) {
    const float* mod = (const float*)(P.ws() + WS_MOD); const float* g = P.in(6); const float* mu = P.in(8);
    bf16_t* XS = (bf16_t*)(P.ws() + WS_BIG);
    for (int r0 = 4 * gw; r0 < T; r0 += 4 * ngw) {
        const bool lat = r0 < NL; const int t0 = lat ? (r0 & 4095) : ((r0 - NL) & 255), L = lat ? SEQ : CTXL, v = lat ? (r0 >> 12) : 4;
        const float* xr = xrow(P.in(0), P.in(2), r0);
        const bool hp = t0 > 0, hn = t0 + 4 < L;
        float ss[6];
#pragma unroll
        for (int i = 0; i < 6; ++i) {
            float s = 0.f;
            if ((i > 0 || hp) && (i < 5 || hn)) {
                const f32x4* p = (const f32x4*)(xr + (ptrdiff_t)(i - 1) * D) + lane;
#pragma unroll
                for (int j = 0; j < 8; ++j) { const f32x4 q = p[64 * j]; s += (q.x * q.x + q.y * q.y) + (q.z * q.z + q.w * q.w); }
            }
            ss[i] = s;
        }
#pragma unroll
        for (int o = 1; o < 64; o <<= 1) {
#pragma unroll
            for (int i = 0; i < 6; ++i) ss[i] += __shfl_xor(ss[i], o);
        }
        float rs[6];
#pragma unroll
        for (int i = 0; i < 6; ++i) rs[i] = rsqrtf(ss[i] * (1.0f / D) + 1e-6f);
        const float* mv = mod + (size_t)v * MODW;
#pragma unroll 1
        for (int j = 0; j < 8; ++j) {
            const int col = 4 * lane + 256 * j;
            const f32x4 gg = *(const f32x4*)(g + col), sc = *(const f32x4*)(mv + 2048 + col), sh = *(const f32x4*)(mv + col);
            const f32x4 A = gg * (sc + 1.0f);
            f32x4 h[6];
#pragma unroll
            for (int i = 0; i < 6; ++i) {
                h[i] = (f32x4){0.f, 0.f, 0.f, 0.f};
                if ((i > 0 || hp) && (i < 5 || hn)) { const f32x4 x = *(const f32x4*)(xr + (ptrdiff_t)(i - 1) * D + col); h[i] = x * rs[i] * A + sh; }
            }
            f32x4 m[6];
#pragma unroll
            for (int q = 0; q < 6; ++q) m[q] = *(const f32x4*)(mu + q * D + col);
#pragma unroll
            for (int i = 0; i < 4; ++i) {
                const f32x4 hc = h[i + 1], xx = (h[i] + h[i + 2]) * 0.5f - hc;
#pragma unroll
                for (int q = 0; q < 6; ++q) {
                    const f32x4 o = hc + xx * m[q];
                    u32x2 w; w.x = cvt_pk_bf16(o.x, o.y); w.y = cvt_pk_bf16(o.z, o.w);
                    constexpr int slot_of[6] = {0, 3, 1, 2, 4, 5};
                    *(u32x2*)(XS + (size_t)slot_of[q] * T * D + (size_t)(r0 + i) * D + col) = w;
                }
            }
        }
    }
}

__device__ __forceinline__ void readout_phase(const KP& P, int gw, int ngw, int lane) {
    const unsigned short* E = (const unsigned short*)(P.ws() + WS_BIG);
    const unsigned short* YF = E + 4 * (size_t)T * D; const unsigned short* YB = E + 5 * (size_t)T * D;
    const bf16_t* G = (const bf16_t*)(P.ws() + WS_BIG);
    bf16_t* Y2 = (bf16_t*)(P.ws() + WS_BIG + S68);
    const bf16_t* Vb = (const bf16_t*)(P.ws() + WS_KV + S68);
    const float* BON = (const float*)(P.ws() + WS_BON);
    const float* gnw = P.in(24); const float* gnb = P.in(25);
    for (int r = gw; r < T; r += ngw) {
#pragma unroll 1
        for (int it = 0; it < 4; it += 2) {
            u32x4 yf[2], yb[2], vv[2], gg[2]; float bon[2];
#pragma unroll
            for (int u = 0; u < 2; ++u) {
                const size_t off = (size_t)r * D + (it + u) * 512 + lane * 8;
                yf[u] = *(const u32x4*)(YF + off); yb[u] = *(const u32x4*)(YB + off); vv[u] = *(const u32x4*)(Vb + off); gg[u] = *(const u32x4*)(G + off);
                const int head = (it + u) * 8 + (lane >> 3);
                bon[u] = BON[(size_t)r * 32 + head] + BON[((size_t)T + r) * 32 + head];
            }
#pragma unroll
            for (int u = 0; u < 2; ++u) {
                const int col = (it + u) * 512 + lane * 8; const size_t off = (size_t)r * D + col;
                float y[8], v8[8], g8[8], gwc[8], gbc[8];
                { const f32x4 p = *(const f32x4*)(gnw + col), q = *(const f32x4*)(gnw + col + 4); gwc[0] = p.x; gwc[1] = p.y; gwc[2] = p.z; gwc[3] = p.w; gwc[4] = q.x; gwc[5] = q.y; gwc[6] = q.z; gwc[7] = q.w; }
                { const f32x4 p = *(const f32x4*)(gnb + col), q = *(const f32x4*)(gnb + col + 4); gbc[0] = p.x; gbc[1] = p.y; gbc[2] = p.z; gbc[3] = p.w; gbc[4] = q.x; gbc[5] = q.y; gbc[6] = q.z; gbc[7] = q.w; }
#pragma unroll
                for (int e = 0; e < 4; ++e) {
                    y[2 * e] = h_lo(yf[u][e]) + h_lo(yb[u][e]); y[2 * e + 1] = h_hi(yf[u][e]) + h_hi(yb[u][e]);
                    v8[2 * e] = bf_lo(vv[u][e]); v8[2 * e + 1] = bf_hi(vv[u][e]); g8[2 * e] = bf_lo(gg[u][e]); g8[2 * e + 1] = bf_hi(gg[u][e]);
                }
                float sy = 0.f;
#pragma unroll
                for (int e = 0; e < 8; ++e) sy += y[e];
                const float mean = red8(sy) * (1.0f / 64.0f);
                float sq = 0.f;
#pragma unroll
                for (int e = 0; e < 8; ++e) { const float dd = y[e] - mean; sq += dd * dd; }
                const float rstd = rsqrtf(red8(sq) * (1.0f / 64.0f) + 64e-5f);
                const float bonus = bon[u];
                float o[8];
#pragma unroll
                for (int e = 0; e < 8; ++e) o[e] = ((y[e] - mean) * rstd * gwc[e] + gbc[e] + bonus * v8[e]) * g8[e];
                u32x4 w; w.x = cvt_pk_bf16(o[0], o[1]); w.y = cvt_pk_bf16(o[2], o[3]); w.z = cvt_pk_bf16(o[4], o[5]); w.w = cvt_pk_bf16(o[6], o[7]);
                *(u32x4*)(Y2 + off) = w;
            }
        }
    }
}

__device__ __forceinline__ void conv_phase(const bf16_t* U, bf16_t* Gf, const float* cw, const float* cb, int nrows, int gtid, int ngt) {
    const long nitems = (long)(nrows / 8) * (DFF / 8);
    for (long it = gtid; it < nitems; it += ngt) {
        const int r0 = (int)(it / (DFF / 8)) * 8, c = (int)(it % (DFF / 8)) * 8;
        const bool lat = r0 < NL; const int t0 = lat ? (r0 & 4095) : ((r0 - NL) & 255), L = lat ? SEQ : CTXL;
        const bf16_t* up = U + (size_t)r0 * (2 * DFF) + c;
        u32x4 gt[10], vl[8];
        gt[0] = (u32x4){0, 0, 0, 0}; gt[9] = (u32x4){0, 0, 0, 0};
        if (t0 > 0) gt[0] = *(const u32x4*)(up - 2 * DFF);
        if (t0 + 8 < L) gt[9] = *(const u32x4*)(up + 8 * (2 * DFF));
#pragma unroll
        for (int i = 0; i < 8; ++i) { gt[i + 1] = *(const u32x4*)(up + (size_t)i * (2 * DFF)); vl[i] = *(const u32x4*)(up + (size_t)i * (2 * DFF) + DFF); }
        float w0[8], w1[8], w2[8], bb[8];
        { const f32x4 a = *(const f32x4*)(cw + c), b = *(const f32x4*)(cw + c + 4); w0[0] = a.x; w0[1] = a.y; w0[2] = a.z; w0[3] = a.w; w0[4] = b.x; w0[5] = b.y; w0[6] = b.z; w0[7] = b.w; }
        { const f32x4 a = *(const f32x4*)(cw + DFF + c), b = *(const f32x4*)(cw + DFF + c + 4); w1[0] = a.x; w1[1] = a.y; w1[2] = a.z; w1[3] = a.w; w1[4] = b.x; w1[5] = b.y; w1[6] = b.z; w1[7] = b.w; }
        { const f32x4 a = *(const f32x4*)(cw + 2 * DFF + c), b = *(const f32x4*)(cw + 2 * DFF + c + 4); w2[0] = a.x; w2[1] = a.y; w2[2] = a.z; w2[3] = a.w; w2[4] = b.x; w2[5] = b.y; w2[6] = b.z; w2[7] = b.w; }
        { const f32x4 a = *(const f32x4*)(cb + c), b = *(const f32x4*)(cb + c + 4); bb[0] = a.x; bb[1] = a.y; bb[2] = a.z; bb[3] = a.w; bb[4] = b.x; bb[5] = b.y; bb[6] = b.z; bb[7] = b.w; }
#pragma unroll
        for (int i = 0; i < 8; ++i) {
            float o[8];
#pragma unroll
            for (int e = 0; e < 4; ++e) {
                const float p0 = bf_lo(gt[i][e]), p1 = bf_hi(gt[i][e]), q0 = bf_lo(gt[i + 1][e]), q1 = bf_hi(gt[i + 1][e]), n0 = bf_lo(gt[i + 2][e]), n1 = bf_hi(gt[i + 2][e]);
                const float g0 = p0 * w0[2 * e] + q0 * w1[2 * e] + n0 * w2[2 * e] + bb[2 * e], g1 = p1 * w0[2 * e + 1] + q1 * w1[2 * e + 1] + n1 * w2[2 * e + 1] + bb[2 * e + 1];
                o[2 * e] = g0 * __builtin_amdgcn_rcpf(1.0f + __expf(-g0)) * bf_lo(vl[i][e]); o[2 * e + 1] = g1 * __builtin_amdgcn_rcpf(1.0f + __expf(-g1)) * bf_hi(vl[i][e]);
            }
            u32x4 w; w.x = cvt_pk_bf16(o[0], o[1]); w.y = cvt_pk_bf16(o[2], o[3]); w.z = cvt_pk_bf16(o[4], o[5]); w.w = cvt_pk_bf16(o[6], o[7]);
            *(u32x4*)(Gf + (size_t)(r0 + i) * DFF + c) = w;
        }
    }
}

__device__ __forceinline__ void fixup_phase(const bf16_t* RAW, const bf16_t* VAL, bf16_t* Gf, const float* cw, const float* cb, int nrows, int gtid, int ngt) {
    const int nitems = (nrows / 64) * 2 * (DFF / 8);
    for (int it = gtid; it < nitems; it += ngt) {
        const int c = (it % (DFF / 8)) * 8, be = it / (DFF / 8), edge = be & 1, blk = be >> 1;
        const int r = blk * 64 + (edge ? 63 : 0);
        const bool lat = r < NL; const int t = lat ? (r & 4095) : ((r - NL) & 255), L = lat ? SEQ : CTXL;
        u32x4 gp = {0, 0, 0, 0}, gn = {0, 0, 0, 0}, gc, vl;
        if (edge == 0) {
            if (t > 0) gp = *(const u32x4*)(RAW + ((size_t)(blk - 1) * 4 + 3) * DFF + c);
            gc = *(const u32x4*)(RAW + ((size_t)blk * 4 + 0) * DFF + c); gn = *(const u32x4*)(RAW + ((size_t)blk * 4 + 1) * DFF + c);
            vl = *(const u32x4*)(VAL + ((size_t)blk * 2 + 0) * DFF + c);
        } else {
            gp = *(const u32x4*)(RAW + ((size_t)blk * 4 + 2) * DFF + c); gc = *(const u32x4*)(RAW + ((size_t)blk * 4 + 3) * DFF + c);
            if (t < L - 1) gn = *(const u32x4*)(RAW + ((size_t)(blk + 1) * 4 + 0) * DFF + c);
            vl = *(const u32x4*)(VAL + ((size_t)blk * 2 + 1) * DFF + c);
        }
        float o[8];
#pragma unroll
        for (int e = 0; e < 4; ++e) {
#pragma unroll
            for (int hh = 0; hh < 2; ++hh) {
                const int ch = c + 2 * e + hh;
                const float p = hh ? bf_hi(gp[e]) : bf_lo(gp[e]), q = hh ? bf_hi(gc[e]) : bf_lo(gc[e]), n = hh ? bf_hi(gn[e]) : bf_lo(gn[e]), vv = hh ? bf_hi(vl[e]) : bf_lo(vl[e]);
                const float gt = p * cw[ch] + q * cw[DFF + ch] + n * cw[2 * DFF + ch] + cb[ch];
                o[2 * e + hh] = gt * __builtin_amdgcn_rcpf(1.0f + __expf(-gt)) * vv;
            }
        }
        u32x4 w; w.x = cvt_pk_bf16(o[0], o[1]); w.y = cvt_pk_bf16(o[2], o[3]); w.z = cvt_pk_bf16(o[4], o[5]); w.w = cvt_pk_bf16(o[6], o[7]);
        *(u32x4*)(Gf + (size_t)r * DFF + c) = w;
    }
}

__device__ __forceinline__ void mla_mid_phase(const KP& P, int gw, int ngw, int lane) {
    const float* CQ = (const float*)(P.ws() + WS_BIG + S68);
    bf16_t* CQn = (bf16_t*)(P.ws() + WS_BIG + 153 * MiB); bf16_t* CKVn = (bf16_t*)(P.ws() + WS_BIG + 170 * MiB); bf16_t* KR = (bf16_t*)(P.ws() + WS_BIG + 187 * MiB);
    const float* qn = P.in(27); const float* kvn = P.in(28);
    for (int r = gw; r < T; r += ngw) {
        const float* row = CQ + (size_t)r * 1280;
#pragma unroll
        for (int part = 0; part < 2; ++part) {
            const f32x4 a = *(const f32x4*)(row + part * 512 + lane * 8), b = *(const f32x4*)(row + part * 512 + lane * 8 + 4);
            const float ss = wave_sum((a.x * a.x + a.y * a.y) + (a.z * a.z + a.w * a.w) + (b.x * b.x + b.y * b.y) + (b.z * b.z + b.w * b.w));
            const float rs = rsqrtf(ss * (1.0f / 512.0f) + 1e-6f);
            const float* gp = (part ? kvn : qn) + lane * 8;
            const f32x4 g0 = *(const f32x4*)gp, g1 = *(const f32x4*)(gp + 4);
            const f32x4 o0 = a * rs * g0, o1 = b * rs * g1;
            u32x4 w; w.x = cvt_pk_bf16(o0.x, o0.y); w.y = cvt_pk_bf16(o0.z, o0.w); w.z = cvt_pk_bf16(o1.x, o1.y); w.w = cvt_pk_bf16(o1.z, o1.w);
            *(u32x4*)((part ? CKVn : CQn) + (size_t)r * 512 + lane * 8) = w;
        }
        if (lane < 32) {
            const int hf = lane >> 4, i = lane & 15;
            const float x1 = row[1024 + hf * 32 + i], x2 = row[1024 + hf * 32 + 16 + i];
            float o1 = x1, o2 = x2;
            if (r < NL) {
                const int t = r & 4095; const float pos = (float)(hf ? (t & 63) : (t >> 6));
                const float ang = pos * exp2f(-(float)i * (13.287712379549449f / 16.0f));
                const float cs = __cosf(ang), sn = __sinf(ang);
                o1 = x1 * cs - x2 * sn; o2 = x2 * cs + x1 * sn;
            }
            KR[(size_t)r * 64 + hf * 32 + i] = (bf16_t)(cvt_pk_bf16(o1, o1) & 0xffffu);
            KR[(size_t)r * 64 + hf * 32 + 16 + i] = (bf16_t)(cvt_pk_bf16(o2, o2) & 0xffffu);
        }
    }
}

__device__ __forceinline__ int scan_row(int chunk, int tk, int d, int b) {
    const int s = chunk * 32 + tk;
    if (chunk < 8) return NL + b * CTXL + (d ? (CTXL - 1 - s) : s);
    const int s2 = s - CTXL; return b * SEQ + (d ? (SEQ - 1 - s2) : s2);
}
__device__ __forceinline__ void scan_phase(const KP& P, LAS unsigned char* lds, const int tid, const int bx, const int G) {
    LAS float* buf = (LAS float*)lds;
    LAS float* ybuf = (LAS float*)(lds + 98304);
    const bf16_t* R = (const bf16_t*)P.out(); const bf16_t* Kb = (const bf16_t*)(P.ws() + WS_KV); const bf16_t* Vb = (const bf16_t*)(P.ws() + WS_KV + S68);
    const unsigned short* EA = (const unsigned short*)(P.ws() + WS_BIG);
    constexpr int NCH = (CTXL + SEQ) / 32;
    for (int u = bx; u < 256; u += G) {
        const int d = u & 1, h = (u >> 1) & 31, b = u >> 6;
        const unsigned short* Ed = EA + (size_t)d * T * D; const unsigned short* Ad = EA + (size_t)(2 + d) * T * D;
        unsigned short* Yd = (unsigned short*)(P.ws() + WS_BIG) + (size_t)(4 + d) * T * D;
        const int tk = tid >> 4, cg = tid & 15, ch = h * 64 + cg * 4;
        const f32x4 kkc = *(const f32x4*)(P.in(21) + ch), kac = *(const f32x4*)(P.in(22) + ch), rkc = *(const f32x4*)(P.in(23) + ch);
        float* BONd = (float*)(P.ws() + WS_BON) + (size_t)d * T * 32;
        const int v = tid >> 3, kc = tid & 7;
        f32x2 S[4];
#pragma unroll
        for (int i = 0; i < 4; ++i) S[i] = (f32x2){0.f, 0.f};
        u32x2 lr, lk, lv, le, la;
#define SC_LOAD(c) do { const size_t off_ = (size_t)scan_row((c), tk, d, b) * D + ch; lr = *(const u32x2*)(R + off_); lk = *(const u32x2*)(Kb + off_); lv = *(const u32x2*)(Vb + off_); \
            le = *(const u32x2*)(Ed + off_); la = *(const u32x2*)(Ad + off_); } while (0)
#define SC_WRITE(bi, cc) do { const f32x4 k4 = {bf_lo(lk.x), bf_hi(lk.x), bf_lo(lk.y), bf_hi(lk.y)}; const f32x4 kx = k4 * kkc; \
            const f32x4 a4 = {h_lo(la.x), h_hi(la.x), h_lo(la.y), h_hi(la.y)}; const f32x4 e4 = {h_lo(le.x), h_hi(le.x), h_lo(le.y), h_hi(le.y)}; \
            const f32x4 kd = k4 * ((a4 - 1.0f) * kac + 1.0f); \
            const f32x4 rq_ = (f32x4){bf_lo(lr.x), bf_hi(lr.x), bf_lo(lr.y), bf_hi(lr.y)} * kd * rkc; \
            float ss_ = (kx.x * kx.x + kx.y * kx.y) + (kx.z * kx.z + kx.w * kx.w), bo_ = (rq_.x + rq_.y) + (rq_.z + rq_.w); \
            ss_ = red16(ss_); bo_ = red16(bo_);        \
            if (cg == 0) BONd[(size_t)scan_row((cc), tk, d, b) * 32 + h] = bo_;        \
            const float inv_ = rsqrtf(fmaxf(ss_, 1e-24f)); const f32x4 kkv = kx * inv_;        \
            const f32x4 bb = kkv * a4; \
            const f32x4 ww = {__expf(-e4.x), __expf(-e4.y), __expf(-e4.z), __expf(-e4.w)}; \
            LAS float* bp_ = buf + (bi) * 12288 + tk * 384 + cg * 4; \
            *(LAS f32x4*)(bp_) = ww; *(LAS f32x4*)(bp_ + 64) = kd; *(LAS f32x4*)(bp_ + 128) = -kkv; *(LAS f32x4*)(bp_ + 192) = bb; \
            *(LAS f32x4*)(bp_ + 256) = (f32x4){bf_lo(lr.x), bf_hi(lr.x), bf_lo(lr.y), bf_hi(lr.y)}; *(LAS f32x4*)(bp_ + 320) = (f32x4){bf_lo(lv.x), bf_hi(lv.x), bf_lo(lv.y), bf_hi(lv.y)}; } while (0)
        __syncthreads();
        SC_LOAD(0); SC_WRITE(0, 0);
        __syncthreads();
#pragma unroll 1
        for (int c = 0; c < NCH; ++c) {
            if (c + 1 < NCH) SC_LOAD(c + 1);
            const LAS float* cb = buf + (c & 1) * 12288 + kc * 8;
#pragma unroll 4
            for (int s = 0; s < 32; ++s) {
                const LAS float* p = cb + s * 384;
                const f32x4 w0 = *(const LAS f32x4*)(p), w1 = *(const LAS f32x4*)(p + 4);
                const f32x4 k0 = *(const LAS f32x4*)(p + 64), k1 = *(const LAS f32x4*)(p + 68);
                const f32x4 a0 = *(const LAS f32x4*)(p + 128), a1 = *(const LAS f32x4*)(p + 132);
                const f32x4 b0 = *(const LAS f32x4*)(p + 192), b1 = *(const LAS f32x4*)(p + 196);
                const f32x4 r0 = *(const LAS f32x4*)(p + 256), r1 = *(const LAS f32x4*)(p + 260);
                const float vv = buf[(c & 1) * 12288 + s * 384 + 320 + v];
                f32x2 sa2 = S[0] * (f32x2){a0.x, a0.y};
                sa2 += S[1] * (f32x2){a0.z, a0.w}; sa2 += S[2] * (f32x2){a1.x, a1.y}; sa2 += S[3] * (f32x2){a1.z, a1.w};
                const float sa = red8(sa2.x + sa2.y);
                const f32x2 sav = {sa, sa}, vv2 = {vv, vv};
                S[0] = S[0] * (f32x2){w0.x, w0.y} + sav * (f32x2){b0.x, b0.y} + vv2 * (f32x2){k0.x, k0.y};
                S[1] = S[1] * (f32x2){w0.z, w0.w} + sav * (f32x2){b0.z, b0.w} + vv2 * (f32x2){k0.z, k0.w};
                S[2] = S[2] * (f32x2){w1.x, w1.y} + sav * (f32x2){b1.x, b1.y} + vv2 * (f32x2){k1.x, k1.y};
                S[3] = S[3] * (f32x2){w1.z, w1.w} + sav * (f32x2){b1.z, b1.w} + vv2 * (f32x2){k1.z, k1.w};
                f32x2 y2 = S[0] * (f32x2){r0.x, r0.y};
                y2 += S[1] * (f32x2){r0.z, r0.w}; y2 += S[2] * (f32x2){r1.x, r1.y}; y2 += S[3] * (f32x2){r1.z, r1.w};
                const float y = red8(y2.x + y2.y);
                if (kc == 0) ybuf[s * 64 + v] = y;
            }
            __syncthreads();
            {
                const f32x4 y4 = *(const LAS f32x4*)(ybuf + tk * 64 + cg * 4);
                u32x2 w; w.x = cvt_pk_f16(y4.x, y4.y); w.y = cvt_pk_f16(y4.z, y4.w);
                *(u32x2*)(Yd + (size_t)scan_row(c, tk, d, b) * D + ch) = w;
            }
            if (c + 1 < NCH) SC_WRITE((c + 1) & 1, c + 1);
            __syncthreads();
        }
#undef SC_LOAD
#undef SC_WRITE
    }
}

namespace att {
constexpr float SCALE = 0.07216878364870323f;
constexpr float THR = 8.f;
constexpr int SHM_T = 16384;
#define KSWZ(row, colB) ((row) * 256 + ((colB) ^ (((row) & 7) << 4)))
#define SBAR() __builtin_amdgcn_sched_barrier(0)
__device__ __forceinline__ int crow(int r, int hi) { return (r & 3) + 8 * (r >> 2) + 4 * hi; }
__device__ __forceinline__ void partialSM(f32x16& p0, f32x16& p1, float& m_reg, float& mn, float& alpha) {
    constexpr float C = SCALE * 1.4426950408889634f;
    float pmax = p0[0];
#pragma unroll
    for (int r = 1; r < 16; ++r) pmax = fmaxf(pmax, p0[r]);
#pragma unroll
    for (int r = 0; r < 16; ++r) pmax = fmaxf(pmax, p1[r]);
    { auto rr = __builtin_amdgcn_permlane32_swap(__float_as_uint(pmax), __float_as_uint(pmax), false, false);
      pmax = fmaxf(__uint_as_float(rr[0]), __uint_as_float(rr[1])); }
    if (__builtin_expect(__all(pmax - m_reg <= THR / SCALE), 1)) { mn = m_reg; alpha = 1.f; }
    else { mn = fmaxf(m_reg, pmax); alpha = __builtin_amdgcn_exp2f((m_reg - mn) * C); m_reg = mn; }
    const float mnC = -mn * C;
#pragma unroll
    for (int r = 0; r < 16; ++r) p0[r] = __builtin_amdgcn_exp2f(fmaf(p0[r], C, mnC));
#pragma unroll
    for (int r = 0; r < 16; ++r) p1[r] = __builtin_amdgcn_exp2f(fmaf(p1[r], C, mnC));
}
__device__ __forceinline__ void finishSM(f32x16& p0, f32x16& p1, float alpha, float& l_reg, bf16x8& pa0, bf16x8& pa1, bf16x8& pa2, bf16x8& pa3) {
    float ps = 0;
#pragma unroll
    for (int r = 0; r < 16; ++r) ps += p0[r];
#pragma unroll
    for (int r = 0; r < 16; ++r) ps += p1[r];
    { auto rr = __builtin_amdgcn_permlane32_swap(__float_as_uint(ps), __float_as_uint(ps), false, false);
      ps = __uint_as_float(rr[0]) + __uint_as_float(rr[1]); }
    l_reg = l_reg * alpha + ps;
#define PK4(P, BASE, OUT) do { unsigned a0 = cvt_pk_bf16(P[BASE + 0], P[BASE + 1]), a1 = cvt_pk_bf16(P[BASE + 2], P[BASE + 3]);   \
    unsigned b0 = cvt_pk_bf16(P[BASE + 4], P[BASE + 5]), b1 = cvt_pk_bf16(P[BASE + 6], P[BASE + 7]);                              \
    auto r0 = __builtin_amdgcn_permlane32_swap(a0, b0, false, false); auto r1 = __builtin_amdgcn_permlane32_swap(a1, b1, false, false); \
    u32x4 w = {r0[0], r1[0], r0[1], r1[1]}; OUT = __builtin_bit_cast(bf16x8, w); } while (0)
    PK4(p0, 0, pa0); PK4(p0, 8, pa1); PK4(p1, 0, pa2); PK4(p1, 8, pa3);
#undef PK4
}
__device__ __forceinline__ void qkt(f32x16& p0, f32x16& p1, const char* Kn, const char* Kr, const bf16x8* qr, int r32, int hi) {
    p0 = f32x16{}; p1 = f32x16{};
#pragma unroll
    for (int d0 = 0; d0 < 8; ++d0) { const int cb = (d0 * 16 + hi * 8) * 2;
        const bf16x8 b0 = *reinterpret_cast<const bf16x8*>(Kn + KSWZ(r32, cb));
        const bf16x8 b1 = *reinterpret_cast<const bf16x8*>(Kn + KSWZ(32 + r32, cb));
        p0 = __builtin_amdgcn_mfma_f32_32x32x16_bf16(b0, qr[d0], p0, 0, 0, 0);
        p1 = __builtin_amdgcn_mfma_f32_32x32x16_bf16(b1, qr[d0], p1, 0, 0, 0); }
#pragma unroll
    for (int d0 = 0; d0 < 4; ++d0) { const int cb = (d0 * 16 + hi * 8) * 2;
        const bf16x8 b0 = *reinterpret_cast<const bf16x8*>(Kr + KSWZ(r32, cb));
        const bf16x8 b1 = *reinterpret_cast<const bf16x8*>(Kr + KSWZ(32 + r32, cb));
        p0 = __builtin_amdgcn_mfma_f32_32x32x16_bf16(b0, qr[8 + d0], p0, 0, 0, 0);
        p1 = __builtin_amdgcn_mfma_f32_32x32x16_bf16(b1, qr[8 + d0], p1, 0, 0, 0); }
}
__device__ __forceinline__ int v_st(int k, int c) { const int kk = (k & ~0xC) | ((k & 4) << 1) | ((k & 8) >> 1); return ((kk >> 3) * 4 + (c >> 5)) * 512 + ((kk & 7) * 32 + (c & 31)) * 2; }
__device__ __forceinline__ int v_rd_base(int lane) { return ((lane & 3) << 3) | (((lane >> 2) & 3) << 6) | (((lane >> 4) & 1) << 5) | (((lane >> 5) & 1) << 8); }
constexpr int v_rd_off(int d0, int ks, int half) { return d0 * 512 + ks * 4096 + half * 2048; }
template <int OFF> __device__ __forceinline__ s16x4 tr_read(int vb) {
    s16x4 r; asm volatile("ds_read_b64_tr_b16 %0, %1 offset:%2" : "=&v"(r) : "v"(vb), "i"(OFF) : "memory"); return r;
}
template <int D0> __device__ __forceinline__ void pv_one(f32x16& od, int vb, bf16x8 pa0, bf16x8 pa1, bf16x8 pa2, bf16x8 pa3) {
    const s16x4 l0 = tr_read<v_rd_off(D0, 0, 0)>(vb), h0 = tr_read<v_rd_off(D0, 0, 1)>(vb), l1 = tr_read<v_rd_off(D0, 1, 0)>(vb), h1 = tr_read<v_rd_off(D0, 1, 1)>(vb);
    const s16x4 l2 = tr_read<v_rd_off(D0, 2, 0)>(vb), h2 = tr_read<v_rd_off(D0, 2, 1)>(vb), l3 = tr_read<v_rd_off(D0, 3, 0)>(vb), h3 = tr_read<v_rd_off(D0, 3, 1)>(vb);
    asm volatile("s_waitcnt lgkmcnt(0)" ::: "memory"); SBAR();
#define PK(L, H) (bf16x8){L[0], L[1], L[2], L[3], H[0], H[1], H[2], H[3]}
    od = __builtin_amdgcn_mfma_f32_32x32x16_bf16(pa0, PK(l0, h0), od, 0, 0, 0);
    od = __builtin_amdgcn_mfma_f32_32x32x16_bf16(pa1, PK(l1, h1), od, 0, 0, 0);
    od = __builtin_amdgcn_mfma_f32_32x32x16_bf16(pa2, PK(l2, h2), od, 0, 0, 0);
    od = __builtin_amdgcn_mfma_f32_32x32x16_bf16(pa3, PK(l3, h3), od, 0, 0, 0);
#undef PK
}
__device__ __forceinline__ void pv_d0(f32x16* o, int vb, bf16x8 pa0, bf16x8 pa1, bf16x8 pa2, bf16x8 pa3) {
    pv_one<0>(o[0], vb, pa0, pa1, pa2, pa3); pv_one<1>(o[1], vb, pa0, pa1, pa2, pa3); pv_one<2>(o[2], vb, pa0, pa1, pa2, pa3); pv_one<3>(o[3], vb, pa0, pa1, pa2, pa3);
}
__device__ __forceinline__ long keyrow(int j, int b) { return j < 4 ? (long)NL + b * CTXL + j * 64 : (long)b * SEQ + (j - 4) * 64; }

__device__ __forceinline__ void attn_unit(const bf16_t* Q, const bf16_t* KV, const bf16_t* KR, bf16_t* O, int b, int h, int qb, char* lds, const int tid) {
    const int wid = tid >> 6, lane = tid & 63, r32 = lane & 31, hi = lane >> 5;
    char* V_lds = lds; char* Kn_lds = lds + 2 * SHM_T; char* Kr_lds = lds + 4 * SHM_T;
    float* wsf = (float*)(lds + 6 * SHM_T) + wid * 64; float* li_l = wsf; float* al_l = wsf + 32;
    float m_reg = -1e30f, l_reg = 0; f32x16 o[4] = {}; bf16x8 qr[12];
    const int tq = qb * 256 + wid * 32 + r32;
    const bf16_t* Qw = Q + ((size_t)b * SEQ + tq) * 3072 + h * 192 + hi * 8;
#pragma unroll
    for (int d0 = 0; d0 < 12; ++d0) qr[d0] = *reinterpret_cast<const bf16x8*>(Qw + d0 * 16);
#pragma unroll
    for (int ax = 0; ax < 2; ++ax) {
        const float pos = (float)(ax ? (tq & 63) : (tq >> 6));
        u32x4 w1 = __builtin_bit_cast(u32x4, qr[8 + 2 * ax]), w2 = __builtin_bit_cast(u32x4, qr[9 + 2 * ax]);
#pragma unroll
        for (int e2 = 0; e2 < 4; ++e2) {
            float o1[2], o2[2];
#pragma unroll
            for (int hh = 0; hh < 2; ++hh) {
                const int i = hi * 8 + e2 * 2 + hh;
                const float ang = pos * exp2f(-(float)i * (13.287712379549449f / 16.0f));
                const float cs = __cosf(ang), sn = __sinf(ang);
                const float x1 = hh ? bf_hi(w1[e2]) : bf_lo(w1[e2]), x2 = hh ? bf_hi(w2[e2]) : bf_lo(w2[e2]);
                o1[hh] = x1 * cs - x2 * sn; o2[hh] = x2 * cs + x1 * sn;
            }
            w1[e2] = cvt_pk_bf16(o1[0], o1[1]); w2[e2] = cvt_pk_bf16(o2[0], o2[1]);
        }
        qr[8 + 2 * ax] = __builtin_bit_cast(bf16x8, w1); qr[9 + 2 * ax] = __builtin_bit_cast(bf16x8, w2);
    }
    const int sr = tid >> 4, sc = (tid & 15) * 8, vst0 = v_st(sr, sc), vst1 = v_st(32 + sr, sc);
    const int krr = tid >> 3, krc = (tid & 7) * 8;
    const int vb0 = (int)(uintptr_t)V_lds + v_rd_base(lane);
    const bf16_t* Kh = KV + h * 256; const bf16_t* Vh = KV + h * 256 + 128;
    bf16x8 sv0, sv1, sk0, sk1, skr;
#define SLOAD(j) do { const long k0_ = keyrow((j), b); sv0 = *reinterpret_cast<const bf16x8*>(Vh + (k0_ + sr) * 4096 + sc); sv1 = *reinterpret_cast<const bf16x8*>(Vh + (k0_ + 32 + sr) * 4096 + sc); \
        sk0 = *reinterpret_cast<const bf16x8*>(Kh + (k0_ + sr) * 4096 + sc); sk1 = *reinterpret_cast<const bf16x8*>(Kh + (k0_ + 32 + sr) * 4096 + sc); \
        skr = *reinterpret_cast<const bf16x8*>(KR + (k0_ + krr) * 64 + krc); } while (0)
#define SWRITE(bi) do { *(bf16x8*)(V_lds + (bi) * SHM_T + vst0) = sv0; *(bf16x8*)(V_lds + (bi) * SHM_T + vst1) = sv1; \
        *(bf16x8*)(Kn_lds + (bi) * SHM_T + KSWZ(sr, sc * 2)) = sk0; *(bf16x8*)(Kn_lds + (bi) * SHM_T + KSWZ(32 + sr, sc * 2)) = sk1; \
        *(bf16x8*)(Kr_lds + (bi) * SHM_T + KSWZ(krr, krc * 2)) = skr; } while (0)
#define RESC(a) do { if (__any((a) < 1.f)) { if (hi == 0) al_l[r32] = (a); asm volatile("s_waitcnt lgkmcnt(0)" ::: "memory"); \
        _Pragma("unroll") for (int d_ = 0; d_ < 4; ++d_) _Pragma("unroll") for (int r_ = 0; r_ < 16; ++r_) o[d_][r_] *= al_l[crow(r_, hi)]; } } while (0)
    constexpr int NT = (CTXL + SEQ) / 64;
    __syncthreads();
    SLOAD(0); SWRITE(0); __syncthreads();
#pragma unroll 1
    for (int j = 0; j < NT; ++j) {
        const int bi = j & 1;
        if (j + 1 < NT) SLOAD(j + 1);
        f32x16 p0, p1; float mn, alpha; bf16x8 pa0, pa1, pa2, pa3;
        qkt(p0, p1, Kn_lds + bi * SHM_T, Kr_lds + bi * SHM_T, qr, r32, hi);
        partialSM(p0, p1, m_reg, mn, alpha);
        finishSM(p0, p1, alpha, l_reg, pa0, pa1, pa2, pa3);
        RESC(alpha);
        SBAR();
        pv_d0(o, vb0 + bi * SHM_T, pa0, pa1, pa2, pa3);
        if (j + 1 < NT) SWRITE(bi ^ 1);
        __syncthreads();
    }
    if (hi == 0) li_l[r32] = l_reg; asm volatile("s_waitcnt lgkmcnt(0)" ::: "memory");
    float rli[16];
#pragma unroll
    for (int r = 0; r < 16; ++r) rli[r] = __builtin_amdgcn_rcpf(li_l[crow(r, hi)]);
    bf16_t* Ow = O + ((size_t)b * SEQ + qb * 256 + wid * 32) * D + h * 128;
#pragma unroll
    for (int r = 0; r < 16; ++r) { const int orow = crow(r, hi);
#pragma unroll
        for (int d0 = 0; d0 < 4; ++d0) { const float val = o[d0][r] * rli[r]; Ow[(size_t)orow * D + d0 * 32 + r32] = (bf16_t)(cvt_pk_bf16(val, val) & 0xffffu); } }
#undef SLOAD
#undef SWRITE
#undef RESC
}
#undef KSWZ
#undef SBAR
}


#define XB_TMO      128
#define XB_XCNT(j)  (256  + 64 * (j))
#define XB_XSUB(j)  (1280 + 64 * (j))
#define XB_XGEN(j)  (2304 + 64 * (j))
#define XB_TOP      3328
#define XB_TOPGEN   3392
#define XCD_BAR_WORDS 3456
#define XB_SPIN_CAP (1u << 22)
__device__ __forceinline__ unsigned xb_ld(unsigned* p)              { return __hip_atomic_load(p, __ATOMIC_RELAXED, __HIP_MEMORY_SCOPE_AGENT); }
__device__ __forceinline__ unsigned xb_add(unsigned* p, unsigned v) { return __hip_atomic_fetch_add(p, v, __ATOMIC_RELAXED, __HIP_MEMORY_SCOPE_AGENT); }
__device__ __forceinline__ unsigned xb_xcc_id() { return (unsigned)__builtin_amdgcn_s_getreg((3 << 11) | 20) & 0xFu; }
#define XB_SPIN(cond, bar) do { unsigned _sp = 0; while (cond) { __builtin_amdgcn_s_sleep(1); \
    if ((++_sp & 255u) == 0u) { if (xb_ld(&(bar)[XB_TMO])) break; if (_sp > XB_SPIN_CAP) { atomicAdd(&(bar)[XB_TMO], 1u); break; } } } } while (0)
struct XcdBarrier { unsigned* bar; unsigned x; volatile LAS unsigned* st; };
__device__ __forceinline__ void xcd_barrier_complete(unsigned* bar, unsigned x, unsigned& nloc, unsigned& nx) {
    const unsigned G = gridDim.x * gridDim.y * gridDim.z;
    unsigned sum, cnt, mine, sp = 0u;
    for (;;) {
        sum = 0u; cnt = 0u; mine = 0u;
#pragma unroll
        for (unsigned j = 0; j < 16; ++j) { const unsigned c = xb_ld(&bar[XB_XCNT(j)]); sum += c; cnt += (c > 0u) ? 1u : 0u; mine = (j == x) ? c : mine; }
        if (sum == G) break;
        __builtin_amdgcn_s_sleep(1);
        if ((++sp & 255u) == 0u) { if (xb_ld(&bar[XB_TMO])) break; if (sp > XB_SPIN_CAP) { atomicAdd(&bar[XB_TMO], 1u); break; } }
    }
    nloc = mine > 0u ? mine : 1u; nx = cnt > 0u ? cnt : 1u;
}
__device__ __forceinline__ void xcd_barrier(const XcdBarrier& b) {
    asm volatile("s_waitcnt vmcnt(0)" ::: "memory");
    __syncthreads();
    if (threadIdx.x == 0) {
        unsigned* bar = b.bar;
        __builtin_amdgcn_s_waitcnt(0);
        unsigned nloc = b.st[0], nx = b.st[1];
        if (nloc == 0u) { xcd_barrier_complete(bar, b.x, nloc, nx); b.st[0] = nloc; b.st[1] = nx; }
        const unsigned old = xb_add(&bar[XB_XSUB(b.x)], 1u);
        const unsigned gen = old / nloc;
        if (old + 1u == (gen + 1u) * nloc) {
            __builtin_amdgcn_fence(__ATOMIC_RELEASE, "agent");
            asm volatile("s_waitcnt vmcnt(0)" ::: "memory");
            const unsigned og = xb_add(&bar[XB_TOP], 1u);
            const unsigned tg = og / nx;
            if (og + 1u == (tg + 1u) * nx) xb_add(&bar[XB_TOPGEN], 1u);
            else XB_SPIN(xb_ld(&bar[XB_TOPGEN]) == tg, bar);
            __builtin_amdgcn_fence(__ATOMIC_ACQUIRE, "agent");
            xb_add(&bar[XB_XGEN(b.x)], 1u);
            asm volatile("s_waitcnt vmcnt(0)" ::: "memory");
        } else {
            XB_SPIN(xb_ld(&bar[XB_XGEN(b.x)]) == gen, bar);
            __builtin_amdgcn_fence(__ATOMIC_ACQUIRE, "agent");
            asm volatile("s_waitcnt vmcnt(0)" ::: "memory");
        }
    }
    __syncthreads();
}

__device__ __forceinline__ void setup_gemm(const KP& P, int ph, int gi, pg8::Gemm& g, pg8::Epi& e) {
    unsigned char* ws = P.ws(); const bf16_t* W = (const bf16_t*)(ws + WS_W); bf16_t* BIG = (bf16_t*)(ws + WS_BIG);
    const float* MOD = (const float*)(ws + WS_MOD);
    e.mode = 0; e.perm = 1; e.acts = 0; e.o0 = nullptr; e.o1 = nullptr; e.o2 = nullptr; e.sCz = 0; e.ldc = D; e.b0 = nullptr; e.b1 = nullptr;
    g.sAz = 0; g.sBz = 0; g.nz = 1; g.M = T;
    const size_t TD = (size_t)T * D;
    switch (ph) {
    case 2:
        if (gi == 0) {
            g.A = BIG; g.lda = D; g.sAz = (int)TD; g.Bt = W + W_RKV / 2; g.ldb = D; g.sBz = D * D; g.N = D; g.K = D; g.nz = 3;
            e.o0 = P.out(); e.o1 = ws + WS_KV; e.o2 = ws + WS_KV + S68; e.ldc = D;
        } else {
            g.A = BIG + 3 * TD; g.lda = D; g.sAz = (int)TD; g.Bt = W + W_L1 / 2; g.ldb = D; g.sBz = 256 * D; g.N = 256; g.K = D; g.nz = 3;
            e.o0 = (unsigned char*)P.out() + S68; e.sCz = (long)T * 256; e.ldc = 256; e.acts = 1 | (0 << 4) | (2 << 8);
        }
        break;
    case 3:
        g.A = (const bf16_t*)((unsigned char*)P.out() + S68) + (size_t)gi * T * 256; g.lda = 256; g.sAz = 64; g.Bt = W + W_L2 / 2 + (size_t)gi * 2 * D * 256; g.ldb = 256; g.sBz = D * 256 + 64; g.N = D; g.K = 128; g.nz = 2;
        e.mode = 1; e.acts = 2 * gi; e.o0 = BIG + (size_t)gi * 2 * TD; e.sCz = (long)TD; e.ldc = D; e.b0 = P.in(13); e.b1 = P.in(16);
        break;
    case 5:
        g.A = (const bf16_t*)((unsigned char*)P.out() + S68) + 2 * (size_t)T * 256; g.lda = 256; g.Bt = W + W_G2 / 2; g.ldb = 256; g.N = D; g.K = 256;
        e.o0 = BIG; e.ldc = D;
        break;
    case 7:
        g.A = BIG + TD; g.lda = D; g.Bt = W + W_RWO / 2; g.ldb = D; g.N = D; g.K = D;
        e.mode = 3; e.perm = 0; e.xin_l = P.in(0); e.xin_c = P.in(2); e.xout_l = P.out(); e.xout_c = (float*)(ws + WS_XC); e.gate = MOD + 4096;
        break;
    case 9:
        g.A = (const bf16_t*)(ws + WS_KV); g.lda = D; g.Bt = W + W_UP / 2; g.ldb = D; g.N = 2 * DFF; g.K = D;
        e.mode = 4; e.o0 = ws + WS_GF; e.o1 = ws + WS_BIG; e.o2 = ws + WS_BIG + 16 * MiB; e.b0 = P.in(33); e.b1 = P.in(34);
        break;
    case 11:
        g.A = (const bf16_t*)(ws + WS_GF); g.lda = DFF; g.Bt = W + W_DN / 2; g.ldb = DFF; g.N = D; g.K = DFF;
        e.mode = 3; e.perm = 0; e.xin_l = P.out(); e.xin_c = (const float*)(ws + WS_XC); e.xout_l = P.out(); e.xout_c = (float*)(ws + WS_XC); e.gate = MOD + 10240;
        break;
    case 13:
        g.A = BIG; g.lda = D; g.Bt = W + W_MLD / 2; g.ldb = D; g.N = 1280; g.K = D;
        e.mode = 2; e.perm = 0; e.o0 = ws + WS_BIG + S68; e.ldc = 1280;
        break;
    case 15:
        if (gi == 0) {
            g.A = (const bf16_t*)(ws + WS_BIG + 153 * MiB); g.lda = 512; g.Bt = W + W_UQ / 2; g.ldb = 512; g.M = NL; g.N = 3072; g.K = 512;
            e.o0 = ws + WS_BIG + 190 * MiB; e.ldc = 3072;
        } else {
            g.A = (const bf16_t*)(ws + WS_BIG + 170 * MiB); g.lda = 512; g.Bt = W + W_UKV / 2; g.ldb = 512; g.N = 4096; g.K = 512;
            e.o0 = ws + WS_KV; e.ldc = 4096;
        }
        break;
    case 17:
        g.A = BIG; g.lda = D; g.Bt = W + W_MLO / 2; g.ldb = D; g.M = NL; g.N = D; g.K = D;
        e.mode = 3; e.perm = 0; e.xin_l = P.out(); e.xin_c = (const float*)(ws + WS_XC); e.xout_l = P.out(); e.xout_c = (float*)(ws + WS_XC); e.gate = MOD + 5 * MODW + 4096;
        break;
    case 19:
        g.A = (const bf16_t*)(ws + WS_KV); g.lda = D; g.Bt = W + W_UP / 2; g.ldb = D; g.M = NL; g.N = 2 * DFF; g.K = D;
        e.mode = 4; e.o0 = ws + WS_GF; e.o1 = ws + WS_BIG; e.o2 = ws + WS_BIG + 16 * MiB; e.b0 = P.in(33) + 3 * DFF; e.b1 = P.in(34) + DFF;
        break;
    default:
        g.A = (const bf16_t*)(ws + WS_GF); g.lda = DFF; g.Bt = W + W_DN / 2; g.ldb = DFF; g.M = NL; g.N = D; g.K = DFF;
        e.mode = 3; e.perm = 0; e.xin_l = P.out(); e.xin_c = (const float*)(ws + WS_XC); e.xout_l = P.out(); e.xout_c = (float*)(ws + WS_XC); e.gate = MOD + 5 * MODW + 10240;
        break;
    }
}

namespace pg8 { __device__ __forceinline__ void make_epi(const EpiSrc& es, Epi& E) { const KP P = kargs(); Gemm g; setup_gemm(P, es.ph, es.gi, g, E); } }
__global__ void __launch_bounds__(512) fwd_megakernel(Params Punused) {
    extern __shared__ __attribute__((aligned(16))) unsigned char lds_raw[];
    cg::grid_group grid = cg::this_grid();
    LAS unsigned char* lds = (LAS unsigned char*)lds_raw;
    volatile LAS unsigned* bst = (volatile LAS unsigned*)(lds + 131072 + 64);
    if (threadIdx.x < 2) bst[threadIdx.x] = 0u;
    __syncthreads();
    if (blockIdx.x == 0) { const KP P0 = kargs(); unsigned* bw = (unsigned*)(P0.ws() + WS_BAR); for (int i = threadIdx.x; i < XCD_BAR_WORDS; i += 512) __hip_atomic_store(bw + i, 0u, __ATOMIC_RELAXED, __HIP_MEMORY_SCOPE_AGENT); }
#ifndef EN_MASK
#define EN_MASK 0xffffffffu
#endif
#define EN(k) (((EN_MASK) >> (k)) & 1u)
#ifndef DUP_MASK
#define DUP_MASK 0u
#endif
#ifndef XSYNC
#define XSYNC 0
#endif
#pragma unroll 1
    for (int ph2 = 0; ph2 < 46; ++ph2) {
        const int ph = ph2 >> 1;
        if ((ph2 & 1) && !(((unsigned)(DUP_MASK) >> ph) & 1u)) continue;
        int tid = threadIdx.x; asm volatile("" : "+v"(tid));
        int bx = blockIdx.x, G = gridDim.x; asm volatile("" : "+s"(bx), "+s"(G));
#define lane (tid & 63)
#define wave (__builtin_amdgcn_readfirstlane(tid >> 6))
#define gw (bx * 8 + wave)
#define ngw (G * 8)
#define gtid (bx * 512 + tid)
#define ngt (G * 512)
        const KP P = kargs();
        unsigned char* ws = P.ws();
        bf16_t* W = (bf16_t*)(ws + WS_W);
        const float* MOD = (const float*)(ws + WS_MOD);
        switch (ph) {
        case 0: if (EN(0)) {
            adaln_tasks(P, lds, tid, bx, G);
            __syncthreads();
            LAS float* scr = (LAS float*)(lds + wave * 16384);
            constexpr int NIT = 4 * 2048 + 4 * 96 + 256 + 256 + 11264 + 5632;
            for (int it = gw; it < NIT; it += ngw) {
                int r = it;
                TR(P.in(9), D, D, W + W_RKV / 2, D, 0)
                TR(P.in(10), D, D, W + W_RKV / 2 + (size_t)D * D, D, 0)
                TR(P.in(11), D, D, W + W_RKV / 2 + 2 * (size_t)D * D, D, 0)
                TR(P.in(12), D, D, W + W_RWO / 2, D, 0)
                TR(P.in(14), D, 96, W + W_L1 / 2, D, 0)
                TR(P.in(14) + D * 96, D, 96, W + W_L1 / 2, D, 96)
                TR(P.in(17), D, 96, W + W_L1 / 2 + 256 * D, D, 0)
                TR(P.in(17) + D * 96, D, 96, W + W_L1 / 2 + 256 * D, D, 96)
                TR(P.in(19), D, 256, W + W_L1 / 2 + 2 * 256 * D, D, 0)
                TR(P.in(20), 256, D, W + W_G2 / 2, 256, 0)
                TRI(P.in(32), D, 2 * DFF, W + W_UP / 2, D)
                TR(P.in(35), DFF, D, W + W_DN / 2, DFF, 0)
            }
            for (int idx = gtid; idx < 4 * D * 256; idx += ngt) {
                const int z = idx >> 19, n = (idx >> 8) & 2047, kk = idx & 255, d = z & 1;
                const float* src = z < 2 ? P.in(15) : P.in(18);
                float val = 0.f; if (kk >= 96 * d && kk < 96 * d + 96) val = src[((size_t)d * 96 + (kk - 96 * d)) * D + n];
                W[W_L2 / 2 + idx] = (bf16_t)(cvt_pk_bf16(val, val) & 0xffffu);
            }
            for (int idx = gtid; idx < 2 * 64 * D; idx += ngt) { const int z = idx / (64 * D), rem = idx % (64 * D); W[W_L1 / 2 + (size_t)z * 256 * D + 192 * D + rem] = 0; }
        } break;
        case 1: if (EN(1)) mix_phase(P, gw, ngw, lane); break;
        case 4: if (EN(4)) scan_phase(P, lds, tid, bx, G); break;
        case 6: if (EN(6)) readout_phase(P, gw, ngw, lane); break;
        case 8: if (EN(8)) modnorm_phase(P.out(), (const float*)(ws + WS_XC), P.in(6) + D, MOD, 6144, 8192, (bf16_t*)(ws + WS_KV), T, gw, ngw, lane); break;
        case 10: if (EN(10)) fixup_phase((const bf16_t*)(ws + WS_BIG), (const bf16_t*)(ws + WS_BIG + 16 * MiB), (bf16_t*)(ws + WS_GF), P.in(33), P.in(34), T, gtid, ngt); break;
        case 12: if (EN(12)) {
            modnorm_phase(P.out(), (const float*)(ws + WS_XC), P.in(6) + 2 * D, MOD + 5 * MODW, 0, 2048, (bf16_t*)(ws + WS_BIG), T, gw, ngw, lane);
            LAS float* scr = (LAS float*)(lds + wave * 16384);
            constexpr int NIT = 32 * 34 + 8 * 96 + 8 * 128 + 2048 + 11264 + 5632;
            for (int it = gw; it < NIT; it += ngw) {
                int r = it;
                TR(P.in(26), D, 1088, W + W_MLD / 2, D, 0)
                TR(P.in(29), 512, 3072, W + W_UQ / 2, 512, 0)
                TR(P.in(30), 512, 4096, W + W_UKV / 2, 512, 0)
                TR(P.in(31), D, D, W + W_MLO / 2, D, 0)
                TRI(P.in(32) + (size_t)D * 2 * DFF, D, 2 * DFF, W + W_UP / 2, D)
                TR(P.in(35) + (size_t)DFF * D, DFF, D, W + W_DN / 2, DFF, 0)
            }
            for (int idx = gtid; idx < 192 * D; idx += ngt) W[W_MLD / 2 + (size_t)1088 * D + idx] = 0;
        } break;
        case 14: if (EN(14)) mla_mid_phase(P, gw, ngw, lane); break;
        case 16: if (EN(16)) {
            const int vcu = (G % 8 == 0) ? (bx % 8) * (G / 8) + bx / 8 : bx;
            for (int u = vcu; u < 1024; u += G) {
                const int bh = u >> 4, qb = u & 15;
                att::attn_unit((const bf16_t*)(ws + WS_BIG + 190 * MiB), (const bf16_t*)(ws + WS_KV), (const bf16_t*)(ws + WS_BIG + 187 * MiB), (bf16_t*)(ws + WS_BIG), bh >> 4, bh & 15, qb, (char*)lds_raw, tid);
            }
        } break;
        case 18: if (EN(18)) modnorm_phase(P.out(), (const float*)(ws + WS_XC), P.in(6) + 3 * D, MOD + 5 * MODW, 6144, 8192, (bf16_t*)(ws + WS_KV), NL, gw, ngw, lane); break;
        case 20: if (EN(20)) fixup_phase((const bf16_t*)(ws + WS_BIG), (const bf16_t*)(ws + WS_BIG + 16 * MiB), (bf16_t*)(ws + WS_GF), P.in(33) + 3 * DFF, P.in(34) + DFF, NL, gtid, ngt); break;
        case 22: if (EN(22)) {
            const float* fg = P.in(7);
            for (int r0 = 4 * gw; r0 < NL; r0 += 4 * ngw) {
                float* xr = P.out() + (size_t)r0 * D;
                f32x4 x[4][8]; float ss[4];
#pragma unroll
                for (int i = 0; i < 4; ++i) {
                    float sq = 0.f;
#pragma unroll
                    for (int j = 0; j < 8; ++j) { x[i][j] = *(const f32x4*)(xr + (size_t)i * D + 4 * lane + 256 * j); sq += (x[i][j].x * x[i][j].x + x[i][j].y * x[i][j].y) + (x[i][j].z * x[i][j].z + x[i][j].w * x[i][j].w); }
                    ss[i] = sq;
                }
#pragma unroll
                for (int o = 1; o < 64; o <<= 1) {
#pragma unroll
                    for (int i = 0; i < 4; ++i) ss[i] += __shfl_xor(ss[i], o);
                }
#pragma unroll
                for (int j = 0; j < 8; ++j) {
                    const int col = 4 * lane + 256 * j; const f32x4 gg = *(const f32x4*)(fg + col);
#pragma unroll
                    for (int i = 0; i < 4; ++i) *(f32x4*)(xr + (size_t)i * D + col) = x[i][j] * rsqrtf(ss[i] * (1.0f / D) + 1e-6f) * gg;
                }
            }
        } break;
        default: if (EN(2)) {
            const int ng = (ph == 2 || ph == 3 || ph == 15) ? 2 : 1;
#pragma unroll 1
            for (int gi = 0; gi < ng; ++gi) {
                pg8::Gemm g; pg8::Epi e; setup_gemm(P, ph, gi, g, e);
                pg8::StaticOrder S; S.init(g.M, g.N, g.nz, G, (ph == 3 && gi == 1) ? (bx + 64) % G : bx);
                pg8::EpiSrc es; es.ph = ph; es.gi = gi;
                pg8::gemm_phase(lds, g, S, es, e.perm | (e.mode == 4 ? 2 : 0), tid);
            }
        } break;
        }
        if (ph == 0) {
            grid.sync();
            if (threadIdx.x == 0) { const KP P1 = kargs(); (void)xb_add((unsigned*)(P1.ws() + WS_BAR) + XB_XCNT(xb_xcc_id()), 1u); }
        } else { XcdBarrier xb2; { const KP P1 = kargs(); xb2.bar = (unsigned*)(P1.ws() + WS_BAR); } xb2.x = xb_xcc_id(); xb2.st = (volatile LAS unsigned*)(lds + 131072 + 64); xcd_barrier(xb2); }
    }
}

#undef lane
#undef wave
#undef gw
#undef ngw
#undef gtid
#undef ngt
extern "C" void kernel_launch(void* const* d_in, const int* in_sizes, int n_in, void* d_out, int out_size, void* d_ws, size_t ws_size, hipStream_t stream) {
    static int grid = 0;
    if (grid == 0) {
        if (n_in != 36 || out_size != NL * D || ws_size < WS_END) { fprintf(stderr, "kernel_launch: unexpected shapes (n_in %d out %d ws %zu)\n", n_in, out_size, ws_size); grid = -1; return; }
        int dev = 0, cus = 0, per_cu = 0;
        hipGetDevice(&dev);
        hipDeviceGetAttribute(&cus, hipDeviceAttributeMultiprocessorCount, dev);
        hipFuncSetAttribute((const void*)fwd_megakernel, hipFuncAttributeMaxDynamicSharedMemorySize, LDS_BYTES);
        hipOccupancyMaxActiveBlocksPerMultiprocessor(&per_cu, (const void*)fwd_megakernel, 512, LDS_BYTES);
        if (per_cu < 1) per_cu = 1;
        grid = cus * per_cu;
        if (grid > 256) grid = 256;
    }
    if (grid < 0) return;
    Params p{};
    for (int i = 0; i < 36; ++i) p.in[i] = (const float*)d_in[i];
    p.out = (float*)d_out; p.ws = (unsigned char*)d_ws;
    void* args[] = {&p};
    hipError_t e = hipLaunchCooperativeKernel((const void*)fwd_megakernel, dim3(grid), dim3(512), args, LDS_BYTES, stream);
    if (e != hipSuccess) fprintf(stderr, "cooperative launch failed: %s (grid %d)\n", hipGetErrorString(e), grid);
}
```

```cpp
#include <hip/hip_runtime.h>
#include <hip/hip_cooperative_groups.h>
#include <cstdio>
#include <cstdint>
namespace cg = cooperative_groups;

#define LAS __attribute__((address_space(3)))
typedef unsigned short bf16_t;
typedef short bf16x8 __attribute__((ext_vector_type(8)));
typedef short s16x4 __attribute__((ext_vector_type(4)));
typedef float f32x4 __attribute__((ext_vector_type(4)));
typedef float f32x2 __attribute__((ext_vector_type(2)));
typedef float f32x16 __attribute__((ext_vector_type(16)));
typedef unsigned u32x4 __attribute__((ext_vector_type(4)));
typedef unsigned u32x2 __attribute__((ext_vector_type(2)));

constexpr int D = 2048, NL = 16384, NC = 1024, T = NL + NC, SEQ = 4096, CTXL = 256, DFF = 5632, MODW = 12288;
constexpr size_t MiB = 1u << 20;
constexpr size_t WS_MOD = 0;
constexpr size_t WS_BAR = 512 * 1024;
constexpr size_t WS_XC = 1 * MiB;
constexpr size_t WS_W = 9 * MiB;
constexpr size_t WS_BIG = 115 * MiB;
constexpr size_t WS_KV = 523 * MiB;
constexpr size_t WS_GF = WS_BIG + 32 * MiB;
constexpr size_t WS_BON = 676 * MiB;
constexpr size_t WS_END = 681 * MiB;
constexpr size_t W_RKV = 0, W_RWO = 24 * MiB, W_L1 = 32 * MiB, W_L2 = 35 * MiB, W_G2 = 39 * MiB, W_UP = 40 * MiB, W_DN = 84 * MiB;
constexpr size_t W_MLD = 0, W_UQ = 5 * MiB, W_UKV = 8 * MiB, W_MLO = 12 * MiB;
constexpr size_t S68 = 68 * MiB;
constexpr int LDS_BYTES = 147456;

struct Params { const float* in[36]; float* out; unsigned char* ws; };
typedef const __attribute__((address_space(4))) unsigned char* kptr_t;
struct KP {
    kptr_t p;
    __device__ __forceinline__ const float* in(int i) const { return *(const float* const __attribute__((address_space(4)))*)(p + 8 * i); }
    __device__ __forceinline__ float* out() const { return *(float* const __attribute__((address_space(4)))*)(p + 288); }
    __device__ __forceinline__ unsigned char* ws() const { return *(unsigned char* const __attribute__((address_space(4)))*)(p + 296); }
};
__device__ __forceinline__ KP kargs() { kptr_t p = (kptr_t)__builtin_amdgcn_kernarg_segment_ptr(); asm volatile("" : "+s"(p)); KP k; k.p = p; return k; }

typedef __bf16 bf16x2_t __attribute__((ext_vector_type(2)));
__device__ __forceinline__ unsigned cvt_pk_bf16(float lo, float hi) { const f32x2 v = {lo, hi}; const bf16x2_t b = __builtin_convertvector(v, bf16x2_t); return __builtin_bit_cast(unsigned, b); }
__device__ __forceinline__ unsigned cvt_pk_f16(float lo, float hi) { _Float16 a = (_Float16)lo, b = (_Float16)hi; return (unsigned)__builtin_bit_cast(unsigned short, a) | ((unsigned)__builtin_bit_cast(unsigned short, b) << 16); }
__device__ __forceinline__ float bf_lo(unsigned w) { return __uint_as_float(w << 16); }
__device__ __forceinline__ float bf_hi(unsigned w) { return __uint_as_float(w & 0xffff0000u); }
__device__ __forceinline__ float h_lo(unsigned w) { return (float)__builtin_bit_cast(_Float16, (unsigned short)(w & 0xffffu)); }
__device__ __forceinline__ float h_hi(unsigned w) { return (float)__builtin_bit_cast(_Float16, (unsigned short)(w >> 16)); }
__device__ __forceinline__ float sigmoidf_(float x) { return __builtin_amdgcn_rcpf(1.0f + __expf(-x)); }
__device__ __forceinline__ float tanhf_(float x) { const float e = __expf(2.0f * x); return 1.0f - 2.0f * __builtin_amdgcn_rcpf(e + 1.0f); }
__device__ __forceinline__ float wave_sum(float v) {
#pragma unroll
    for (int o = 1; o < 64; o <<= 1) v += __shfl_xor(v, o);
    return v;
}
template <int CTRL> __device__ __forceinline__ float dpp_mov(float x) { return __int_as_float(__builtin_amdgcn_update_dpp(0, __float_as_int(x), CTRL, 0xF, 0xF, true)); }
__device__ __forceinline__ float red8(float x) { x += dpp_mov<0xB1>(x); x += dpp_mov<0x4E>(x); x += dpp_mov<0x141>(x); return x; }
__device__ __forceinline__ float red16(float x) { x += dpp_mov<0xB1>(x); x += dpp_mov<0x4E>(x); x += dpp_mov<0x141>(x); x += dpp_mov<0x140>(x); return x; }

namespace pg8 {
constexpr int BM = 256, BK = 64, HALF = 128, HTB = HALF * BK * 2, STAGE_BYTES = 8 * HTB, NXCD = 8, WGM = 8;
__device__ __forceinline__ int lds_byte(int r, int c) { const int st = (r >> 4) * 2 + (c >> 5), rr = r & 15, cc = c & 31, ob = rr * 64 + cc * 2; return st * 1024 + (ob ^ (((ob >> 9) & 1) << 5)); }
__device__ __forceinline__ void stage_rc(int b, int& R, int& C) { const int st = b / 1024, sb = b % 1024, swz = sb ^ (((sb >> 9) & 1) << 5); R = (st >> 1) * 16 + swz / 64; C = (st & 1) * 32 + (swz % 64) / 2; }
__device__ __forceinline__ int perm32(int rho) { const int n = rho >> 4, i = rho & 15; return 8 * (i >> 2) + 4 * n + (i & 3); }

struct Unit { int pm, pn, z; };
struct Gemm { const bf16_t* A; const bf16_t* Bt; int lda, ldb; int sAz, sBz; int M, N, K, nz; };
struct StaticOrder {
    int nM, nN, nwg, G, c, tot;
    __device__ void init(int M, int N, int nz, int G_, int c_) { nM = M / BM; nN = N / BM; nwg = nM * nN; G = G_; c = c_; tot = nwg * nz; }
    __device__ bool next(int i, Unit& u) const {
        const long L = (long)i * G + c; if (L >= tot) return false;
        u.z = (int)(L / nwg);
        int wgid = (int)(L % nwg); { const int q = nwg / NXCD, r = nwg % NXCD, xcd = wgid % NXCD, off = wgid / NXCD; wgid = (xcd < r ? xcd * (q + 1) : r * (q + 1) + (xcd - r) * q) + off; }
        const int nig = WGM * nN, gid = wgid / nig, fm = gid * WGM, gsz = (nM - fm) < WGM ? (nM - fm) : WGM;
        u.pm = fm + ((wgid % nig) % gsz); u.pn = (wgid % nig) / gsz; return true;
    }
};

struct Epi {
    int mode;
    int perm;
    int acts;
    int ldc; long sCz;
    union { void* o0; const float* xin_l; };
    union { void* o1; const float* xin_c; };
    union { void* o2; float* xout_l; };
    union { const float* b0; float* xout_c; };
    union { const float* b1; const float* gate; };
};
__device__ __forceinline__ void epilogue(const Epi& E, const f32x4 (&acc)[2][2][4][2], const Unit& u, int wr, int wc, int fr, int fq) {
    if (E.mode == 4) {
        bf16_t* Gf = (bf16_t*)E.o0; bf16_t* RAW = (bf16_t*)E.o1; bf16_t* VAL = (bf16_t*)E.o2;
        const int ch0 = u.pn * HALF + wc * 32 + 8 * fq;
        f32x4 cw0[2], cw1[2], cw2[2], cbb[2];
#pragma unroll
        for (int n = 0; n < 2; ++n) { cw0[n] = *(const f32x4*)(E.b0 + ch0 + 4 * n); cw1[n] = *(const f32x4*)(E.b0 + DFF + ch0 + 4 * n); cw2[n] = *(const f32x4*)(E.b0 + 2 * DFF + ch0 + 4 * n); cbb[n] = *(const f32x4*)(E.b1 + ch0 + 4 * n); }
#pragma unroll
        for (int ai = 0; ai < 2; ++ai) {
            const int rowb = u.pm * BM + ai * HALF + wr * 64, blk = rowb >> 6;
#pragma unroll
            for (int m = 0; m < 4; ++m) {
                float o[8];
#pragma unroll
                for (int n = 0; n < 2; ++n) {
                    const f32x4 c0 = cw0[n], c1 = cw1[n], c2 = cw2[n], cbv = cbb[n];
#pragma unroll
                    for (int e = 0; e < 4; ++e) {
                        const float gc = acc[ai][0][m][n][e];
                        const float gp = m > 0 ? acc[ai][0][m > 0 ? m - 1 : 0][n][e] : dpp_mov<0x121>(acc[ai][0][3][n][e]);
                        const float gn = m < 3 ? acc[ai][0][m < 3 ? m + 1 : 3][n][e] : dpp_mov<0x12F>(acc[ai][0][0][n][e]);
                        const float gt = gp * c0[e] + gc * c1[e] + gn * c2[e] + cbv[e];
                        o[4 * n + e] = gt * __builtin_amdgcn_rcpf(1.0f + __expf(-gt)) * acc[ai][1][m][n][e];
                    }
                }
                u32x4 w; w.x = cvt_pk_bf16(o[0], o[1]); w.y = cvt_pk_bf16(o[2], o[3]); w.z = cvt_pk_bf16(o[4], o[5]); w.w = cvt_pk_bf16(o[6], o[7]);
                *(u32x4*)(Gf + (size_t)(rowb + 4 * fr + m) * DFF + ch0) = w;
                {
                    const int br = 4 * fr + m;
                    const int slot = br == 0 ? 0 : br == 1 ? 1 : br == 62 ? 2 : br == 63 ? 3 : -1;
                    if (slot >= 0) {
                        u32x4 g; g.x = cvt_pk_bf16(acc[ai][0][m][0][0], acc[ai][0][m][0][1]); g.y = cvt_pk_bf16(acc[ai][0][m][0][2], acc[ai][0][m][0][3]);
                        g.z = cvt_pk_bf16(acc[ai][0][m][1][0], acc[ai][0][m][1][1]); g.w = cvt_pk_bf16(acc[ai][0][m][1][2], acc[ai][0][m][1][3]);
                        *(u32x4*)(RAW + ((size_t)blk * 4 + slot) * DFF + ch0) = g;
                        if (slot == 0 || slot == 3) {
                            u32x4 vv; vv.x = cvt_pk_bf16(acc[ai][1][m][0][0], acc[ai][1][m][0][1]); vv.y = cvt_pk_bf16(acc[ai][1][m][0][2], acc[ai][1][m][0][3]);
                            vv.z = cvt_pk_bf16(acc[ai][1][m][1][0], acc[ai][1][m][1][1]); vv.w = cvt_pk_bf16(acc[ai][1][m][1][2], acc[ai][1][m][1][3]);
                            *(u32x4*)(VAL + ((size_t)blk * 2 + (slot ? 1 : 0)) * DFF + ch0) = vv;
                        }
                    }
                }
                asm volatile("" ::: "memory");
            }
        }
        return;
    }
    if (E.mode <= 1) {
        unsigned short* base = (u.z == 1 && E.o1) ? (unsigned short*)E.o1 : (u.z == 2 && E.o2) ? (unsigned short*)E.o2 : (unsigned short*)E.o0 + (size_t)u.z * E.sCz;
        const int row0 = u.pm * BM + wr * 64 + fr, col0 = u.pn * BM + wc * 32 + 8 * fq;
        const int act = E.mode == 0 ? ((E.acts >> (4 * u.z)) & 15) : 0;
        f32x4 bv[2][2];
#pragma unroll
        for (int bj = 0; bj < 2; ++bj)
#pragma unroll
            for (int n = 0; n < 2; ++n) bv[bj][n] = (f32x4){0.f, 0.f, 0.f, 0.f};
        if (E.mode == 1) {
            const int zz = u.z + E.acts;
            const float* bp = (zz < 2 ? E.b0 + zz * D : E.b1 + (zz - 2) * D) + col0;
#pragma unroll
            for (int bj = 0; bj < 2; ++bj)
#pragma unroll
                for (int n = 0; n < 2; ++n) bv[bj][n] = *(const f32x4*)(bp + bj * HALF + 4 * n);
        }
#pragma unroll
        for (int ai = 0; ai < 2; ++ai)
#pragma unroll
            for (int m = 0; m < 4; ++m) {
                unsigned short* rowp = base + (size_t)(row0 + ai * HALF + m * 16) * E.ldc + col0;
#pragma unroll
                for (int bj = 0; bj < 2; ++bj) {
                    f32x4 v0 = acc[ai][bj][m][0] + bv[bj][0], v1 = acc[ai][bj][m][1] + bv[bj][1];
                    u32x4 w;
                    if (E.mode == 0) {
                        if (act == 1) {
#pragma unroll
                            for (int e = 0; e < 4; ++e) { v0[e] = tanhf_(v0[e]); v1[e] = tanhf_(v1[e]); }
                        } else if (act == 2) {
#pragma unroll
                            for (int e = 0; e < 4; ++e) { v0[e] = sigmoidf_(v0[e]); v1[e] = sigmoidf_(v1[e]); }
                        }
                        w.x = cvt_pk_bf16(v0[0], v0[1]); w.y = cvt_pk_bf16(v0[2], v0[3]); w.z = cvt_pk_bf16(v1[0], v1[1]); w.w = cvt_pk_bf16(v1[2], v1[3]);
                    } else {
                        const float sc = (u.z + E.acts < 2) ? 0.6065306597126334f : 1.0f;
#pragma unroll
                        for (int e = 0; e < 4; ++e) {
                            v0[e] = sc * __builtin_amdgcn_rcpf(1.0f + __builtin_amdgcn_exp2f(fmaf(acc[ai][bj][m][0][e], -1.4426950408889634f, -1.4426950408889634f * bv[bj][0][e])));
                            v1[e] = sc * __builtin_amdgcn_rcpf(1.0f + __builtin_amdgcn_exp2f(fmaf(acc[ai][bj][m][1][e], -1.4426950408889634f, -1.4426950408889634f * bv[bj][1][e])));
                        }
                        w.x = cvt_pk_f16(v0[0], v0[1]); w.y = cvt_pk_f16(v0[2], v0[3]); w.z = cvt_pk_f16(v1[0], v1[1]); w.w = cvt_pk_f16(v1[2], v1[3]);
                    }
                    *(u32x4*)(rowp + bj * HALF) = w;
                }
                asm volatile("" ::: "memory");
            }
    } else {
        const int col0 = u.pn * BM + wc * 32 + 4 * fq;
        const int rowt = u.pm * BM;
        if (E.mode == 2) {
            float* base = (float*)E.o0;
#pragma unroll
            for (int ai = 0; ai < 2; ++ai)
#pragma unroll
                for (int m = 0; m < 4; ++m) {
                    float* rowp = base + (size_t)(rowt + ai * HALF + wr * 64 + m * 16 + fr) * E.ldc + col0;
#pragma unroll
                    for (int bj = 0; bj < 2; ++bj)
#pragma unroll
                        for (int n = 0; n < 2; ++n) *(f32x4*)(rowp + bj * HALF + n * 16) = acc[ai][bj][m][n];
                    asm volatile("" ::: "memory");
                }
        } else {
            const bool lat = rowt < NL;
            const int v = lat ? (rowt >> 12) : 4;
            const float* xin = lat ? E.xin_l + (size_t)rowt * D : E.xin_c + (size_t)(rowt - NL) * D;
            float* xout = lat ? E.xout_l + (size_t)rowt * D : E.xout_c + (size_t)(rowt - NL) * D;
            const float* gp = E.gate + (size_t)v * MODW + col0;
            f32x4 gv[2][2];
#pragma unroll
            for (int bj = 0; bj < 2; ++bj)
#pragma unroll
                for (int n = 0; n < 2; ++n) gv[bj][n] = *(const f32x4*)(gp + bj * HALF + n * 16);
#pragma unroll
            for (int ai = 0; ai < 2; ++ai)
#pragma unroll
                for (int mp = 0; mp < 4; mp += 2) {
                    f32x4 xi[2][2][2];
#pragma unroll
                    for (int m = 0; m < 2; ++m) {
                        const size_t off = (size_t)(ai * HALF + wr * 64 + (mp + m) * 16 + fr) * D + col0;
#pragma unroll
                        for (int bj = 0; bj < 2; ++bj)
#pragma unroll
                            for (int n = 0; n < 2; ++n) xi[m][bj][n] = *(const f32x4*)(xin + off + bj * HALF + n * 16);
                    }
                    asm volatile("" ::: "memory");
#pragma unroll
                    for (int m = 0; m < 2; ++m) {
                        const size_t off = (size_t)(ai * HALF + wr * 64 + (mp + m) * 16 + fr) * D + col0;
#pragma unroll
                        for (int bj = 0; bj < 2; ++bj)
#pragma unroll
                            for (int n = 0; n < 2; ++n) *(f32x4*)(xout + off + bj * HALF + n * 16) = xi[m][bj][n] + gv[bj][n] * acc[ai][bj][mp + m][n];
                    }
                    asm volatile("" ::: "memory");
                }
        }
    }
}

struct EpiSrc { int ph, gi; };
__device__ __forceinline__ void make_epi(const EpiSrc& es, Epi& E);
__device__ __forceinline__ void gemm_phase(LAS unsigned char* lds, const Gemm g, const StaticOrder& S, const EpiSrc es, const int perm, const int tid) {
    const int wid = __builtin_amdgcn_readfirstlane(tid >> 6), lane = tid & 63, wr = wid >> 2, wc = wid & 3, fr = lane & 15, fq = lane >> 4;
    const int K = g.K, nt = K / BK;
    unsigned voffA, voffB;
    { int R, C; stage_rc(tid * 16, R, C); const int Rb = (perm & 1) ? ((R & ~31) + perm32(R & 31)) : R;
        const int Ra = (perm & 2) ? ((R & ~63) + 4 * (R & 15) + ((R >> 4) & 3)) : R;
        voffA = (unsigned)(Ra * g.lda + C) * 2u; voffB = (unsigned)(Rb * g.ldb + C) * 2u; }
    const unsigned kstep = BK * 2;
    const unsigned hstepA = (unsigned)HALF * g.lda * 2, hstepB = (unsigned)HALF * g.ldb * 2;
    const unsigned tstepA = 2 * hstepA, tstepB = 2 * hstepB;
    const unsigned r64voffA = hstepA >> 1, r64voffB = hstepB >> 1; const unsigned voffA_ = voffA, voffB_ = voffB;
    const unsigned ldsw = (unsigned)wid * 1024u;
    const int aoff = lds_byte(wr * 64 + fr, fq * 8), boff = lds_byte(wc * 32 + fr, fq * 8);
#define PG8_SA(b, h) (((b) * 2 + (h)) * HTB)
#define PG8_SB(b, h) ((4 + (b) * 2 + (h)) * HTB)
#define PG8_STAGE(bufoff, gbase, voff) do { _Pragma("unroll") for (int _i = 0; _i < 2; ++_i) \
        __builtin_amdgcn_global_load_lds((const unsigned*)((const char*)(gbase) + _i * r64##voff + voff##_), (LAS unsigned*)(lds + (bufoff) + ldsw + _i * 8192), 16, 0, 0); } while (0)
#define PG8_LDA(dst, b, h) do { _Pragma("unroll") for (int m = 0; m < 4; ++m) _Pragma("unroll") for (int k = 0; k < 2; ++k) dst[m][k] = *(const LAS bf16x8*)(lds + PG8_SA(b, h) + aoff + m * 2048 + k * 1024); } while (0)
#define PG8_LDB(dst, b, h) do { _Pragma("unroll") for (int n = 0; n < 2; ++n) _Pragma("unroll") for (int k = 0; k < 2; ++k) dst[n][k] = *(const LAS bf16x8*)(lds + PG8_SB(b, h) + boff + n * 2048 + k * 1024); } while (0)
#define PG8_MMA(ai, bj, At, Bt) do { __builtin_amdgcn_s_setprio(1); _Pragma("unroll") for (int m = 0; m < 4; ++m) _Pragma("unroll") for (int n = 0; n < 2; ++n) _Pragma("unroll") for (int k = 0; k < 2; ++k) \
        acc[ai][bj][m][n] = __builtin_amdgcn_mfma_f32_16x16x32_bf16(Bt[n][k], At[m][k], acc[ai][bj][m][n], 0, 0, 0); __builtin_amdgcn_s_setprio(0); } while (0)
#define PG8_WAIT_V(n) asm volatile("s_waitcnt vmcnt(" #n ")" ::: "memory")
#define PG8_WAIT_L(n) asm volatile("s_waitcnt lgkmcnt(" #n ")" ::: "memory")
#define PG8_BAR __builtin_amdgcn_s_barrier()
#define PG8_SCHED __builtin_amdgcn_sched_barrier(0)
    Unit cur, nxt; int ui = 0;
    if (!S.next(0, cur)) return;
    f32x4 acc[2][2][4][2];
#pragma unroll
    for (int a = 0; a < 2; ++a)
#pragma unroll
        for (int b = 0; b < 2; ++b)
#pragma unroll
            for (int m = 0; m < 4; ++m)
#pragma unroll
                for (int n = 0; n < 2; ++n) acc[a][b][m][n] = (f32x4){0.f, 0.f, 0.f, 0.f};
    bf16x8 At[4][2], B0[2][2], B1[2][2];
    const char* cA = (const char*)g.A + (size_t)((unsigned)cur.z * (unsigned)g.sAz * 2u + (unsigned)cur.pm * tstepA); const char* cB = (const char*)g.Bt + (size_t)((unsigned)cur.z * (unsigned)g.sBz * 2u + (unsigned)cur.pn * tstepB);
    PG8_STAGE(PG8_SB(0, 0), cB, voffB); PG8_STAGE(PG8_SB(0, 1), cB + hstepB, voffB); PG8_STAGE(PG8_SA(0, 0), cA, voffA); PG8_STAGE(PG8_SA(0, 1), cA + hstepA, voffA);
    if (wr == 1) PG8_BAR;
    PG8_WAIT_V(2); PG8_BAR;
    PG8_STAGE(PG8_SB(1, 0), cB + kstep, voffB); PG8_STAGE(PG8_SA(1, 0), cA + kstep, voffA); PG8_STAGE(PG8_SB(1, 1), cB + hstepB + kstep, voffB);
    PG8_WAIT_V(6); PG8_BAR;
    for (;;) {
        const bool has_next = S.next(ui + 1, nxt);
        const char* nA = has_next ? (const char*)g.A + (size_t)((unsigned)nxt.z * (unsigned)g.sAz * 2u + (unsigned)nxt.pm * tstepA) : cA; const char* nB = has_next ? (const char*)g.Bt + (size_t)((unsigned)nxt.z * (unsigned)g.sBz * 2u + (unsigned)nxt.pn * tstepB) : cB;
        for (int t = 0; t < nt; t += 2) {
            const bool last = (t == nt - 2);
            const char* a1 = cA + (size_t)(t + 1) * kstep;
            const char* a2 = last ? nA : cA + (size_t)(t + 2) * kstep; const char* b2 = last ? nB : cB + (size_t)(t + 2) * kstep;
            const char* a3 = a2 + kstep; const char* b3 = b2 + kstep;
            PG8_LDB(B0, 0, 0); PG8_LDB(B1, 0, 1); PG8_SCHED; PG8_LDA(At, 0, 0); PG8_STAGE(PG8_SA(1, 1), a1 + hstepA, voffA);
            PG8_WAIT_V(8); PG8_WAIT_L(0); PG8_BAR; PG8_MMA(0, 0, At, B0); PG8_MMA(0, 1, At, B1); PG8_BAR; PG8_SCHED;
            PG8_LDA(At, 0, 1); PG8_STAGE(PG8_SB(0, 0), b2, voffB); PG8_STAGE(PG8_SB(0, 1), b2 + hstepB, voffB); PG8_STAGE(PG8_SA(0, 0), a2, voffA);
            PG8_WAIT_V(8); PG8_WAIT_L(0); PG8_BAR; PG8_MMA(1, 0, At, B0); PG8_MMA(1, 1, At, B1); PG8_BAR; PG8_SCHED;
            PG8_LDB(B0, 1, 0); PG8_LDB(B1, 1, 1); PG8_SCHED; PG8_LDA(At, 1, 0); PG8_STAGE(PG8_SA(0, 1), a2 + hstepA, voffA);
            PG8_WAIT_V(8); PG8_WAIT_L(0); PG8_BAR; PG8_MMA(0, 0, At, B0); PG8_MMA(0, 1, At, B1); PG8_BAR; PG8_SCHED;
            PG8_LDA(At, 1, 1); PG8_STAGE(PG8_SB(1, 0), b3, voffB); PG8_STAGE(PG8_SB(1, 1), b3 + hstepB, voffB); PG8_STAGE(PG8_SA(1, 0), a3, voffA);
            PG8_WAIT_V(8); PG8_WAIT_L(0); PG8_BAR; PG8_MMA(1, 0, At, B0); PG8_MMA(1, 1, At, B1); PG8_BAR; PG8_SCHED;
        }
        if (wr == 0) PG8_BAR;
        { Epi E; make_epi(es, E); epilogue(E, acc, cur, wr, wc, fr, fq); }
        if (!has_next) break;
#pragma unroll
        for (int a = 0; a < 2; ++a)
#pragma unroll
            for (int b = 0; b < 2; ++b)
#pragma unroll
                for (int m = 0; m < 4; ++m)
#pragma unroll
                    for (int n = 0; n < 2; ++n) acc[a][b][m][n] = (f32x4){0.f, 0.f, 0.f, 0.f};
        cur = nxt; cA = nA; cB = nB; ++ui;
        if (wr == 1) PG8_BAR;
    }
    PG8_WAIT_V(0);
    PG8_BAR;
#undef PG8_SA
#undef PG8_SB
#undef PG8_STAGE
#undef PG8_LDA
#undef PG8_LDB
#undef PG8_MMA
#undef PG8_WAIT_V
#undef PG8_WAIT_L
#undef PG8_BAR
#undef PG8_SCHED
}
}

__device__ __forceinline__ void transpose_item(const float* W, int K, int N, bf16_t* WT, int ldo, int row_off, LAS float* scr, int item, int lane, int ilv = 0) {
    const int nblk = N / 32, kb = item / nblk, nb = item % nblk, k0 = 64 * kb, n0 = 32 * nb;
    float tv[32];
    const float* wp = W + (size_t)(k0 + (lane >> 5)) * N + n0 + (lane & 31);
#pragma unroll
    for (int i = 0; i < 32; ++i) tv[i] = wp[(size_t)(2 * i) * N];
#pragma unroll
    for (int i = 0; i < 32; ++i) scr[(2 * i + (lane >> 5)) * 33 + (lane & 31)] = tv[i];
    asm volatile("s_waitcnt lgkmcnt(0)" ::: "memory");
    const int c = lane & 7;
#pragma unroll
    for (int j = 0; j < 4; ++j) { const int n = (lane >> 3) + 8 * j; const LAS float* s = scr + (8 * c) * 33 + n;
        u32x4 o; o.x = cvt_pk_bf16(s[0 * 33], s[1 * 33]); o.y = cvt_pk_bf16(s[2 * 33], s[3 * 33]); o.z = cvt_pk_bf16(s[4 * 33], s[5 * 33]); o.w = cvt_pk_bf16(s[6 * 33], s[7 * 33]);
        const int nn = n0 + n; const int orow = ilv ? (nn >= DFF ? (((nn - DFF) >> 7) * 256 + 128 + ((nn - DFF) & 127)) : ((nn >> 7) * 256 + (nn & 127))) : row_off + nn;
        *(u32x4*)(WT + (size_t)orow * ldo + k0 + 8 * c) = o; }
    asm volatile("s_waitcnt lgkmcnt(0)" ::: "memory");
}
#define TR(src, K_, N_, dst, ldo, roff) { const int items_ = ((K_) / 64) * ((N_) / 32); if (r < items_) { transpose_item((src), (K_), (N_), (dst), (ldo), (roff), scr, r, lane); continue; } r -= items_; }
#define TRI(src, K_, N_, dst, ldo) { const int items_ = ((K_) / 64) * ((N_) / 32); if (r < items_) { transpose_item((src), (K_), (N_), (dst), (ldo), 0, scr, r, lane, 1); continue; } r -= items_; }

__device__ __forceinline__ void adaln_tasks(const KP& P, LAS unsigned char* lds, const int tid, const int bx, const int G) {
    if (bx >= 192) return;
    LAS float* sv = (LAS float*)lds;
    LAS float* red = (LAS float*)(lds + 40960);
    for (int i = tid; i < 5 * D; i += 512) { const int v = i >> 11, k = i & 2047; const float x = v < 4 ? P.in(1)[v * D + k] : P.in(3)[k]; sv[i] = x * __builtin_amdgcn_rcpf(1.0f + __expf(-x)); }
    __syncthreads();
    float* MOD = (float*)(P.ws() + WS_MOD);
    for (int task = bx; task < 192; task += G) {
        const int li = task / 96, cb = task % 96, cg = tid & 31, ks = tid >> 5;
        const float* wp = P.in(4) + (size_t)li * D * MODW + (size_t)(ks * 128) * MODW + cb * 128 + cg * 4;
        f32x4 a0 = {0, 0, 0, 0}, a1 = a0, a2 = a0, a3 = a0, a4 = a0;
#pragma unroll 16
        for (int k = 0; k < 128; ++k) {
            const f32x4 w = *(const f32x4*)(wp + (size_t)k * MODW);
            const int kk = ks * 128 + k;
            a0 += w * sv[kk]; a1 += w * sv[D + kk]; a2 += w * sv[2 * D + kk]; a3 += w * sv[3 * D + kk]; a4 += w * sv[4 * D + kk];
        }
        LAS f32x4* rp = (LAS f32x4*)(red + ks * 640 + cg * 4);
        rp[0] = a0; rp[32] = a1; rp[64] = a2; rp[96] = a3; rp[128] = a4;
        __syncthreads();
        for (int o = tid; o < 640; o += 512) {
            float s = 0.f;
#pragma unroll
            for (int q = 0; q < 16; ++q) s += red[q * 640 + o];
            const int v = o >> 7, cc = o & 127, col = cb * 128 + cc;
            MOD[((size_t)li * 5 + v) * MODW + col] = s + P.in(5)[li * MODW + col];
        }
        __syncthreads();
    }
}

__device__ __forceinline__ const float* xrow(const float* xl, const float* xc, int r) { return r < NL ? xl + (size_t)r * D : xc + (size_t)(r - NL) * D; }
__device__ __forceinline__ float row_rstd(const float* xr, int lane) {
    const f32x4* p = (const f32x4*)xr + lane; float s = 0.f;
#pragma unroll
    for (int j = 0; j < 8; ++j) { const f32x4 v = p[64 * j]; s += (v.x * v.x + v.y * v.y) + (v.z * v.z + v.w * v.w); }
    return rsqrtf(wave_sum(s) * (1.0f / D) + 1e-6f);
}
__device__ __forceinline__ void modnorm_phase(const float* xl, const float* xc, const float* g, const float* mod, int shift_off, int scale_off, bf16_t* out, int nrows, int gw, int ngw, int lane) {
    for (int r0 = 4 * gw; r0 < nrows; r0 += 4 * ngw) {
        const float* xr = xrow(xl, xc, r0); const int v = r0 < NL ? (r0 >> 12) : 4;
        f32x4 x[4][8]; float ss[4];
#pragma unroll
        for (int i = 0; i < 4; ++i) {
            float s = 0.f;
#pragma unroll
            for (int j = 0; j < 8; ++j) { x[i][j] = *(const f32x4*)(xr + (size_t)i * D + 4 * lane + 256 * j); s += (x[i][j].x * x[i][j].x + x[i][j].y * x[i][j].y) + (x[i][j].z * x[i][j].z + x[i][j].w * x[i][j].w); }
            ss[i] = s;
        }
#pragma unroll
        for (int o = 1; o < 64; o <<= 1) {
#pragma unroll
            for (int i = 0; i < 4; ++i) ss[i] += __shfl_xor(ss[i], o);
        }
        float rs[4];
#pragma unroll
        for (int i = 0; i < 4; ++i) rs[i] = rsqrtf(ss[i] * (1.0f / D) + 1e-6f);
        const float* mv = mod + (size_t)v * MODW;
#pragma unroll
        for (int j = 0; j < 8; ++j) {
            const int col = 4 * lane + 256 * j;
            const f32x4 gg = *(const f32x4*)(g + col), sc = *(const f32x4*)(mv + scale_off + col), sh = *(const f32x4*)(mv + shift_off + col);
            const f32x4 A = gg * (sc + 1.0f);
#pragma unroll
            for (int i = 0; i < 4; ++i) {
                const f32x4 h = x[i][j] * rs[i] * A + sh;
                u32x2 w; w.x = cvt_pk_bf16(h.x, h.y); w.y = cvt_pk_bf16(h.z, h.w);
                *(u32x2*)(out + (size_t)(r0 + i) * D + col) = w;
            }
        }
    }
}
__device__ __forceinline__ void mix_phase(const KP& P, int gw, int ngw, int lane) {
    const float* mod = (const float*)(P.ws() + WS_MOD); const float* g = P.in(6); const float* mu = P.in(8);
    bf16_t* XS = (bf16_t*)(P.ws() + WS_BIG);
    for (int r0 = 4 * gw; r0 < T; r0 += 4 * ngw) {
        const bool lat = r0 < NL; const int t0 = lat ? (r0 & 4095) : ((r0 - NL) & 255), L = lat ? SEQ : CTXL, v = lat ? (r0 >> 12) : 4;
        const float* xr = xrow(P.in(0), P.in(2), r0);
        const bool hp = t0 > 0, hn = t0 + 4 < L;
        float ss[6];
#pragma unroll
        for (int i = 0; i < 6; ++i) {
            float s = 0.f;
            if ((i > 0 || hp) && (i < 5 || hn)) {
                const f32x4* p = (const f32x4*)(xr + (ptrdiff_t)(i - 1) * D) + lane;
#pragma unroll
                for (int j = 0; j < 8; ++j) { const f32x4 q = p[64 * j]; s += (q.x * q.x + q.y * q.y) + (q.z * q.z + q.w * q.w); }
            }
            ss[i] = s;
        }
#pragma unroll
        for (int o = 1; o < 64; o <<= 1) {
#pragma unroll
            for (int i = 0; i < 6; ++i) ss[i] += __shfl_xor(ss[i], o);
        }
        float rs[6];
#pragma unroll
        for (int i = 0; i < 6; ++i) rs[i] = rsqrtf(ss[i] * (1.0f / D) + 1e-6f);
        const float* mv = mod + (size_t)v * MODW;
#pragma unroll 1
        for (int j = 0; j < 8; ++j) {
            const int col = 4 * lane + 256 * j;
            const f32x4 gg = *(const f32x4*)(g + col), sc = *(const f32x4*)(mv + 2048 + col), sh = *(const f32x4*)(mv + col);
            const f32x4 A = gg * (sc + 1.0f);
            f32x4 h[6];
#pragma unroll
            for (int i = 0; i < 6; ++i) {
                h[i] = (f32x4){0.f, 0.f, 0.f, 0.f};
                if ((i > 0 || hp) && (i < 5 || hn)) { const f32x4 x = *(const f32x4*)(xr + (ptrdiff_t)(i - 1) * D + col); h[i] = x * rs[i] * A + sh; }
            }
            f32x4 m[6];
#pragma unroll
            for (int q = 0; q < 6; ++q) m[q] = *(const f32x4*)(mu + q * D + col);
#pragma unroll
            for (int i = 0; i < 4; ++i) {
                const f32x4 hc = h[i + 1], xx = (h[i] + h[i + 2]) * 0.5f - hc;
#pragma unroll
                for (int q = 0; q < 6; ++q) {
                    const f32x4 o = hc + xx * m[q];
                    u32x2 w; w.x = cvt_pk_bf16(o.x, o.y); w.y = cvt_pk_bf16(o.z, o.w);
                    constexpr int slot_of[6] = {0, 3, 1, 2, 4, 5};
                    *(u32x2*)(XS + (size_t)slot_of[q] * T * D + (size_t)(r0 + i) * D + col) = w;
                }
            }
        }
    }
}

__device__ __forceinline__ void readout_phase(const KP& P, int gw, int ngw, int lane) {
    const unsigned short* E = (const unsigned short*)(P.ws() + WS_BIG);
    const unsigned short* YF = E + 4 * (size_t)T * D; const unsigned short* YB = E + 5 * (size_t)T * D;
    const bf16_t* G = (const bf16_t*)(P.ws() + WS_BIG);
    bf16_t* Y2 = (bf16_t*)(P.ws() + WS_BIG + S68);
    const bf16_t* Vb = (const bf16_t*)(P.ws() + WS_KV + S68);
    const float* BON = (const float*)(P.ws() + WS_BON);
    const float* gnw = P.in(24); const float* gnb = P.in(25);
    for (int r = gw; r < T; r += ngw) {
#pragma unroll 1
        for (int it = 0; it < 4; it += 2) {
            u32x4 yf[2], yb[2], vv[2], gg[2]; float bon[2];
#pragma unroll
            for (int u = 0; u < 2; ++u) {
                const size_t off = (size_t)r * D + (it + u) * 512 + lane * 8;
                yf[u] = *(const u32x4*)(YF + off); yb[u] = *(const u32x4*)(YB + off); vv[u] = *(const u32x4*)(Vb + off); gg[u] = *(const u32x4*)(G + off);
                const int head = (it + u) * 8 + (lane >> 3);
                bon[u] = BON[(size_t)r * 32 + head] + BON[((size_t)T + r) * 32 + head];
            }
#pragma unroll
            for (int u = 0; u < 2; ++u) {
                const int col = (it + u) * 512 + lane * 8; const size_t off = (size_t)r * D + col;
                float y[8], v8[8], g8[8], gwc[8], gbc[8];
                { const f32x4 p = *(const f32x4*)(gnw + col), q = *(const f32x4*)(gnw + col + 4); gwc[0] = p.x; gwc[1] = p.y; gwc[2] = p.z; gwc[3] = p.w; gwc[4] = q.x; gwc[5] = q.y; gwc[6] = q.z; gwc[7] = q.w; }
                { const f32x4 p = *(const f32x4*)(gnb + col), q = *(const f32x4*)(gnb + col + 4); gbc[0] = p.x; gbc[1] = p.y; gbc[2] = p.z; gbc[3] = p.w; gbc[4] = q.x; gbc[5] = q.y; gbc[6] = q.z; gbc[7] = q.w; }
#pragma unroll
                for (int e = 0; e < 4; ++e) {
                    y[2 * e] = h_lo(yf[u][e]) + h_lo(yb[u][e]); y[2 * e + 1] = h_hi(yf[u][e]) + h_hi(yb[u][e]);
                    v8[2 * e] = bf_lo(vv[u][e]); v8[2 * e + 1] = bf_hi(vv[u][e]); g8[2 * e] = bf_lo(gg[u][e]); g8[2 * e + 1] = bf_hi(gg[u][e]);
                }
                float sy = 0.f;
#pragma unroll
                for (int e = 0; e < 8; ++e) sy += y[e];
                const float mean = red8(sy) * (1.0f / 64.0f);
                float sq = 0.f;
#pragma unroll
                for (int e = 0; e < 8; ++e) { const float dd = y[e] - mean; sq += dd * dd; }
                const float rstd = rsqrtf(red8(sq) * (1.0f / 64.0f) + 64e-5f);
                const float bonus = bon[u];
                float o[8];
#pragma unroll
                for (int e = 0; e < 8; ++e) o[e] = ((y[e] - mean) * rstd * gwc[e] + gbc[e] + bonus * v8[e]) * g8[e];
                u32x4 w; w.x = cvt_pk_bf16(o[0], o[1]); w.y = cvt_pk_bf16(o[2], o[3]); w.z = cvt_pk_bf16(o[4], o[5]); w.w = cvt_pk_bf16(o[6], o[7]);
                *(u32x4*)(Y2 + off) = w;
            }
        }
    }
}

__device__ __forceinline__ void conv_phase(const bf16_t* U, bf16_t* Gf, const float* cw, const float* cb, int nrows, int gtid, int ngt) {
    const long nitems = (long)(nrows / 8) * (DFF / 8);
    for (long it = gtid; it < nitems; it += ngt) {
        const int r0 = (int)(it / (DFF / 8)) * 8, c = (int)(it % (DFF / 8)) * 8;
        const bool lat = r0 < NL; const int t0 = lat ? (r0 & 4095) : ((r0 - NL) & 255), L = lat ? SEQ : CTXL;
        const bf16_t* up = U + (size_t)r0 * (2 * DFF) + c;
        u32x4 gt[10], vl[8];
        gt[0] = (u32x4){0, 0, 0, 0}; gt[9] = (u32x4){0, 0, 0, 0};
        if (t0 > 0) gt[0] = *(const u32x4*)(up - 2 * DFF);
        if (t0 + 8 < L) gt[9] = *(const u32x4*)(up + 8 * (2 * DFF));
#pragma unroll
        for (int i = 0; i < 8; ++i) { gt[i + 1] = *(const u32x4*)(up + (size_t)i * (2 * DFF)); vl[i] = *(const u32x4*)(up + (size_t)i * (2 * DFF) + DFF); }
        float w0[8], w1[8], w2[8], bb[8];
        { const f32x4 a = *(const f32x4*)(cw + c), b = *(const f32x4*)(cw + c + 4); w0[0] = a.x; w0[1] = a.y; w0[2] = a.z; w0[3] = a.w; w0[4] = b.x; w0[5] = b.y; w0[6] = b.z; w0[7] = b.w; }
        { const f32x4 a = *(const f32x4*)(cw + DFF + c), b = *(const f32x4*)(cw + DFF + c + 4); w1[0] = a.x; w1[1] = a.y; w1[2] = a.z; w1[3] = a.w; w1[4] = b.x; w1[5] = b.y; w1[6] = b.z; w1[7] = b.w; }
        { const f32x4 a = *(const f32x4*)(cw + 2 * DFF + c), b = *(const f32x4*)(cw + 2 * DFF + c + 4); w2[0] = a.x; w2[1] = a.y; w2[2] = a.z; w2[3] = a.w; w2[4] = b.x; w2[5] = b.y; w2[6] = b.z; w2[7] = b.w; }
        { const f32x4 a = *(const f32x4*)(cb + c), b = *(const f32x4*)(cb + c + 4); bb[0] = a.x; bb[1] = a.y; bb[2] = a.z; bb[3] = a.w; bb[4] = b.x; bb[5] = b.y; bb[6] = b.z; bb[7] = b.w; }
#pragma unroll
        for (int i = 0; i < 8; ++i) {
            float o[8];
#pragma unroll
            for (int e = 0; e < 4; ++e) {
                const float p0 = bf_lo(gt[i][e]), p1 = bf_hi(gt[i][e]), q0 = bf_lo(gt[i + 1][e]), q1 = bf_hi(gt[i + 1][e]), n0 = bf_lo(gt[i + 2][e]), n1 = bf_hi(gt[i + 2][e]);
                const float g0 = p0 * w0[2 * e] + q0 * w1[2 * e] + n0 * w2[2 * e] + bb[2 * e], g1 = p1 * w0[2 * e + 1] + q1 * w1[2 * e + 1] + n1 * w2[2 * e + 1] + bb[2 * e + 1];
                o[2 * e] = g0 * __builtin_amdgcn_rcpf(1.0f + __expf(-g0)) * bf_lo(vl[i][e]); o[2 * e + 1] = g1 * __builtin_amdgcn_rcpf(1.0f + __expf(-g1)) * bf_hi(vl[i][e]);
            }
            u32x4 w; w.x = cvt_pk_bf16(o[0], o[1]); w.y = cvt_pk_bf16(o[2], o[3]); w.z = cvt_pk_bf16(o[4], o[5]); w.w = cvt_pk_bf16(o[6], o[7]);
            *(u32x4*)(Gf + (size_t)(r0 + i) * DFF + c) = w;
        }
    }
}

__device__ __forceinline__ void fixup_phase(const bf16_t* RAW, const bf16_t* VAL, bf16_t* Gf, const float* cw, const float* cb, int nrows, int gtid, int ngt) {
    const int nitems = (nrows / 64) * 2 * (DFF / 8);
    for (int it = gtid; it < nitems; it += ngt) {
        const int c = (it % (DFF / 8)) * 8, be = it / (DFF / 8), edge = be & 1, blk = be >> 1;
        const int r = blk * 64 + (edge ? 63 : 0);
        const bool lat = r < NL; const int t = lat ? (r & 4095) : ((r - NL) & 255), L = lat ? SEQ : CTXL;
        u32x4 gp = {0, 0, 0, 0}, gn = {0, 0, 0, 0}, gc, vl;
        if (edge == 0) {
            if (t > 0) gp = *(const u32x4*)(RAW + ((size_t)(blk - 1) * 4 + 3) * DFF + c);
            gc = *(const u32x4*)(RAW + ((size_t)blk * 4 + 0) * DFF + c); gn = *(const u32x4*)(RAW + ((size_t)blk * 4 + 1) * DFF + c);
            vl = *(const u32x4*)(VAL + ((size_t)blk * 2 + 0) * DFF + c);
        } else {
            gp = *(const u32x4*)(RAW + ((size_t)blk * 4 + 2) * DFF + c); gc = *(const u32x4*)(RAW + ((size_t)blk * 4 + 3) * DFF + c);
            if (t < L - 1) gn = *(const u32x4*)(RAW + ((size_t)(blk + 1) * 4 + 0) * DFF + c);
            vl = *(const u32x4*)(VAL + ((size_t)blk * 2 + 1) * DFF + c);
        }
        float o[8];
#pragma unroll
        for (int e = 0; e < 4; ++e) {
#pragma unroll
            for (int hh = 0; hh < 2; ++hh) {
                const int ch = c + 2 * e + hh;
                const float p = hh ? bf_hi(gp[e]) : bf_lo(gp[e]), q = hh ? bf_hi(gc[e]) : bf_lo(gc[e]), n = hh ? bf_hi(gn[e]) : bf_lo(gn[e]), vv = hh ? bf_hi(vl[e]) : bf_lo(vl[e]);
                const float gt = p * cw[ch] + q * cw[DFF + ch] + n * cw[2 * DFF + ch] + cb[ch];
                o[2 * e + hh] = gt * __builtin_amdgcn_rcpf(1.0f + __expf(-gt)) * vv;
            }
        }
        u32x4 w; w.x = cvt_pk_bf16(o[0], o[1]); w.y = cvt_pk_bf16(o[2], o[3]); w.z = cvt_pk_bf16(o[4], o[5]); w.w = cvt_pk_bf16(o[6], o[7]);
        *(u32x4*)(Gf + (size_t)r * DFF + c) = w;
    }
}

__device__ __forceinline__ void mla_mid_phase(const KP& P, int gw, int ngw, int lane) {
    const float* CQ = (const float*)(P.ws() + WS_BIG + S68);
    bf16_t* CQn = (bf16_t*)(P.ws() + WS_BIG + 153 * MiB); bf16_t* CKVn = (bf16_t*)(P.ws() + WS_BIG + 170 * MiB); bf16_t* KR = (bf16_t*)(P.ws() + WS_BIG + 187 * MiB);
    const float* qn = P.in(27); const float* kvn = P.in(28);
    for (int r = gw; r < T; r += ngw) {
        const float* row = CQ + (size_t)r * 1280;
#pragma unroll
        for (int part = 0; part < 2; ++part) {
            const f32x4 a = *(const f32x4*)(row + part * 512 + lane * 8), b = *(const f32x4*)(row + part * 512 + lane * 8 + 4);
            const float ss = wave_sum((a.x * a.x + a.y * a.y) + (a.z * a.z + a.w * a.w) + (b.x * b.x + b.y * b.y) + (b.z * b.z + b.w * b.w));
            const float rs = rsqrtf(ss * (1.0f / 512.0f) + 1e-6f);
            const float* gp = (part ? kvn : qn) + lane * 8;
            const f32x4 g0 = *(const f32x4*)gp, g1 = *(const f32x4*)(gp + 4);
            const f32x4 o0 = a * rs * g0, o1 = b * rs * g1;
            u32x4 w; w.x = cvt_pk_bf16(o0.x, o0.y); w.y = cvt_pk_bf16(o0.z, o0.w); w.z = cvt_pk_bf16(o1.x, o1.y); w.w = cvt_pk_bf16(o1.z, o1.w);
            *(u32x4*)((part ? CKVn : CQn) + (size_t)r * 512 + lane * 8) = w;
        }
        if (lane < 32) {
            const int hf = lane >> 4, i = lane & 15;
            const float x1 = row[1024 + hf * 32 + i], x2 = row[1024 + hf * 32 + 16 + i];
            float o1 = x1, o2 = x2;
            if (r < NL) {
                const int t = r & 4095; const float pos = (float)(hf ? (t & 63) : (t >> 6));
                const float ang = pos * exp2f(-(float)i * (13.287712379549449f / 16.0f));
                const float cs = __cosf(ang), sn = __sinf(ang);
                o1 = x1 * cs - x2 * sn; o2 = x2 * cs + x1 * sn;
            }
            KR[(size_t)r * 64 + hf * 32 + i] = (bf16_t)(cvt_pk_bf16(o1, o1) & 0xffffu);
            KR[(size_t)r * 64 + hf * 32 + 16 + i] = (bf16_t)(cvt_pk_bf16(o2, o2) & 0xffffu);
        }
    }
}

__device__ __forceinline__ int scan_row(int chunk, int tk, int d, int b) {
    const int s = chunk * 32 + tk;
    if (chunk < 8) return NL + b * CTXL + (d ? (CTXL - 1 - s) : s);
    const int s2 = s - CTXL; return b * SEQ + (d ? (SEQ - 1 - s2) : s2);
}
__device__ __forceinline__ void scan_phase(const KP& P, LAS unsigned char* lds, const int tid, const int bx, const int G) {
    LAS float* buf = (LAS float*)lds;
    LAS float* ybuf = (LAS float*)(lds + 98304);
    const bf16_t* R = (const bf16_t*)P.out(); const bf16_t* Kb = (const bf16_t*)(P.ws() + WS_KV); const bf16_t* Vb = (const bf16_t*)(P.ws() + WS_KV + S68);
    const unsigned short* EA = (const unsigned short*)(P.ws() + WS_BIG);
    constexpr int NCH = (CTXL + SEQ) / 32;
    for (int u = bx; u < 256; u += G) {
        const int d = u & 1, h = (u >> 1) & 31, b = u >> 6;
        const unsigned short* Ed = EA + (size_t)d * T * D; const unsigned short* Ad = EA + (size_t)(2 + d) * T * D;
        unsigned short* Yd = (unsigned short*)(P.ws() + WS_BIG) + (size_t)(4 + d) * T * D;
        const int tk = tid >> 4, cg = tid & 15, ch = h * 64 + cg * 4;
        const f32x4 kkc = *(const f32x4*)(P.in(21) + ch), kac = *(const f32x4*)(P.in(22) + ch), rkc = *(const f32x4*)(P.in(23) + ch);
        float* BONd = (float*)(P.ws() + WS_BON) + (size_t)d * T * 32;
        const int v = tid >> 3, kc = tid & 7;
        f32x2 S[4];
#pragma unroll
        for (int i = 0; i < 4; ++i) S[i] = (f32x2){0.f, 0.f};
        u32x2 lr, lk, lv, le, la;
#define SC_LOAD(c) do { const size_t off_ = (size_t)scan_row((c), tk, d, b) * D + ch; lr = *(const u32x2*)(R + off_); lk = *(const u32x2*)(Kb + off_); lv = *(const u32x2*)(Vb + off_); \
            le = *(const u32x2*)(Ed + off_); la = *(const u32x2*)(Ad + off_); } while (0)
#define SC_WRITE(bi, cc) do { const f32x4 k4 = {bf_lo(lk.x), bf_hi(lk.x), bf_lo(lk.y), bf_hi(lk.y)}; const f32x4 kx = k4 * kkc; \
            const f32x4 a4 = {h_lo(la.x), h_hi(la.x), h_lo(la.y), h_hi(la.y)}; const f32x4 e4 = {h_lo(le.x), h_hi(le.x), h_lo(le.y), h_hi(le.y)}; \
            const f32x4 kd = k4 * ((a4 - 1.0f) * kac + 1.0f); \
            const f32x4 rq_ = (f32x4){bf_lo(lr.x), bf_hi(lr.x), bf_lo(lr.y), bf_hi(lr.y)} * kd * rkc; \
            float ss_ = (kx.x * kx.x + kx.y * kx.y) + (kx.z * kx.z + kx.w * kx.w), bo_ = (rq_.x + rq_.y) + (rq_.z + rq_.w); \
            ss_ = red16(ss_); bo_ = red16(bo_);        \
            if (cg == 0) BONd[(size_t)scan_row((cc), tk, d, b) * 32 + h] = bo_;        \
            const float inv_ = rsqrtf(fmaxf(ss_, 1e-24f)); const f32x4 kkv = kx * inv_;        \
            const f32x4 bb = kkv * a4; \
            const f32x4 ww = {__expf(-e4.x), __expf(-e4.y), __expf(-e4.z), __expf(-e4.w)}; \
            LAS float* bp_ = buf + (bi) * 12288 + tk * 384 + cg * 4; \
            *(LAS f32x4*)(bp_) = ww; *(LAS f32x4*)(bp_ + 64) = kd; *(LAS f32x4*)(bp_ + 128) = -kkv; *(LAS f32x4*)(bp_ + 192) = bb; \
            *(LAS f32x4*)(bp_ + 256) = (f32x4){bf_lo(lr.x), bf_hi(lr.x), bf_lo(lr.y), bf_hi(lr.y)}; *(LAS f32x4*)(bp_ + 320) = (f32x4){bf_lo(lv.x), bf_hi(lv.x), bf_lo(lv.y), bf_hi(lv.y)}; } while (0)
        __syncthreads();
        SC_LOAD(0); SC_WRITE(0, 0);
        __syncthreads();
#pragma unroll 1
        for (int c = 0; c < NCH; ++c) {
            if (c + 1 < NCH) SC_LOAD(c + 1);
            const LAS float* cb = buf + (c & 1) * 12288 + kc * 8;
#pragma unroll 8
            for (int s = 0; s < 32; ++s) {
                const LAS float* p = cb + s * 384;
                const f32x4 w0 = *(const LAS f32x4*)(p), w1 = *(const LAS f32x4*)(p + 4);
                const f32x4 k0 = *(const LAS f32x4*)(p + 64), k1 = *(const LAS f32x4*)(p + 68);
                const f32x4 a0 = *(const LAS f32x4*)(p + 128), a1 = *(const LAS f32x4*)(p + 132);
                const f32x4 b0 = *(const LAS f32x4*)(p + 192), b1 = *(const LAS f32x4*)(p + 196);
                const f32x4 r0 = *(const LAS f32x4*)(p + 256), r1 = *(const LAS f32x4*)(p + 260);
                const float vv = buf[(c & 1) * 12288 + s * 384 + 320 + v];
                f32x2 sa2 = S[0] * (f32x2){a0.x, a0.y};
                sa2 += S[1] * (f32x2){a0.z, a0.w}; sa2 += S[2] * (f32x2){a1.x, a1.y}; sa2 += S[3] * (f32x2){a1.z, a1.w};
                const float sa = red8(sa2.x + sa2.y);
                const f32x2 sav = {sa, sa}, vv2 = {vv, vv};
                S[0] = S[0] * (f32x2){w0.x, w0.y} + sav * (f32x2){b0.x, b0.y} + vv2 * (f32x2){k0.x, k0.y};
                S[1] = S[1] * (f32x2){w0.z, w0.w} + sav * (f32x2){b0.z, b0.w} + vv2 * (f32x2){k0.z, k0.w};
                S[2] = S[2] * (f32x2){w1.x, w1.y} + sav * (f32x2){b1.x, b1.y} + vv2 * (f32x2){k1.x, k1.y};
                S[3] = S[3] * (f32x2){w1.z, w1.w} + sav * (f32x2){b1.z, b1.w} + vv2 * (f32x2){k1.z, k1.w};
                f32x2 y2 = S[0] * (f32x2){r0.x, r0.y};
                y2 += S[1] * (f32x2){r0.z, r0.w}; y2 += S[2] * (f32x2){r1.x, r1.y}; y2 += S[3] * (f32x2){r1.z, r1.w};
                const float y = red8(y2.x + y2.y);
                if (kc == 0) ybuf[s * 64 + v] = y;
            }
            __syncthreads();
            {
                const f32x4 y4 = *(const LAS f32x4*)(ybuf + tk * 64 + cg * 4);
                u32x2 w; w.x = cvt_pk_f16(y4.x, y4.y); w.y = cvt_pk_f16(y4.z, y4.w);
                *(u32x2*)(Yd + (size_t)scan_row(c, tk, d, b) * D + ch) = w;
            }
            if (c + 1 < NCH) SC_WRITE((c + 1) & 1, c + 1);
            __syncthreads();
        }
#undef SC_LOAD
#undef SC_WRITE
    }
}

namespace att {
constexpr float SCALE = 0.07216878364870323f;
constexpr float THR = 8.f;
constexpr int SHM_T = 16384;
#define KSWZ(row, colB) ((row) * 256 + ((colB) ^ (((row) & 7) << 4)))
#define SBAR() __builtin_amdgcn_sched_barrier(0)
__device__ __forceinline__ int crow(int r, int hi) { return (r & 3) + 8 * (r >> 2) + 4 * hi; }
__device__ __forceinline__ void partialSM(f32x16& p0, f32x16& p1, float& m_reg, float& mn, float& alpha) {
    constexpr float C = SCALE * 1.4426950408889634f;
    float pmax = p0[0];
#pragma unroll
    for (int r = 1; r < 16; ++r) pmax = fmaxf(pmax, p0[r]);
#pragma unroll
    for (int r = 0; r < 16; ++r) pmax = fmaxf(pmax, p1[r]);
    { auto rr = __builtin_amdgcn_permlane32_swap(__float_as_uint(pmax), __float_as_uint(pmax), false, false);
      pmax = fmaxf(__uint_as_float(rr[0]), __uint_as_float(rr[1])); }
    if (__builtin_expect(__all(pmax - m_reg <= THR / SCALE), 1)) { mn = m_reg; alpha = 1.f; }
    else { mn = fmaxf(m_reg, pmax); alpha = __builtin_amdgcn_exp2f((m_reg - mn) * C); m_reg = mn; }
    const float mnC = -mn * C;
#pragma unroll
    for (int r = 0; r < 16; ++r) p0[r] = __builtin_amdgcn_exp2f(fmaf(p0[r], C, mnC));
#pragma unroll
    for (int r = 0; r < 16; ++r) p1[r] = __builtin_amdgcn_exp2f(fmaf(p1[r], C, mnC));
}
__device__ __forceinline__ void finishSM(f32x16& p0, f32x16& p1, float alpha, float& l_reg, bf16x8& pa0, bf16x8& pa1, bf16x8& pa2, bf16x8& pa3) {
    float ps = 0;
#pragma unroll
    for (int r = 0; r < 16; ++r) ps += p0[r];
#pragma unroll
    for (int r = 0; r < 16; ++r) ps += p1[r];
    { auto rr = __builtin_amdgcn_permlane32_swap(__float_as_uint(ps), __float_as_uint(ps), false, false);
      ps = __uint_as_float(rr[0]) + __uint_as_float(rr[1]); }
    l_reg = l_reg * alpha + ps;
#define PK4(P, BASE, OUT) do { unsigned a0 = cvt_pk_bf16(P[BASE + 0], P[BASE + 1]), a1 = cvt_pk_bf16(P[BASE + 2], P[BASE + 3]);   \
    unsigned b0 = cvt_pk_bf16(P[BASE + 4], P[BASE + 5]), b1 = cvt_pk_bf16(P[BASE + 6], P[BASE + 7]);                              \
    auto r0 = __builtin_amdgcn_permlane32_swap(a0, b0, false, false); auto r1 = __builtin_amdgcn_permlane32_swap(a1, b1, false, false); \
    u32x4 w = {r0[0], r1[0], r0[1], r1[1]}; OUT = __builtin_bit_cast(bf16x8, w); } while (0)
    PK4(p0, 0, pa0); PK4(p0, 8, pa1); PK4(p1, 0, pa2); PK4(p1, 8, pa3);
#undef PK4
}
__device__ __forceinline__ void qkt(f32x16& p0, f32x16& p1, const char* Kn, const char* Kr, const bf16x8* qr, int r32, int hi) {
    p0 = f32x16{}; p1 = f32x16{};
#pragma unroll
    for (int d0 = 0; d0 < 8; ++d0) { const int cb = (d0 * 16 + hi * 8) * 2;
        const bf16x8 b0 = *reinterpret_cast<const bf16x8*>(Kn + KSWZ(r32, cb));
        const bf16x8 b1 = *reinterpret_cast<const bf16x8*>(Kn + KSWZ(32 + r32, cb));
        p0 = __builtin_amdgcn_mfma_f32_32x32x16_bf16(b0, qr[d0], p0, 0, 0, 0);
        p1 = __builtin_amdgcn_mfma_f32_32x32x16_bf16(b1, qr[d0], p1, 0, 0, 0); }
#pragma unroll
    for (int d0 = 0; d0 < 4; ++d0) { const int cb = (d0 * 16 + hi * 8) * 2;
        const bf16x8 b0 = *reinterpret_cast<const bf16x8*>(Kr + KSWZ(r32, cb));
        const bf16x8 b1 = *reinterpret_cast<const bf16x8*>(Kr + KSWZ(32 + r32, cb));
        p0 = __builtin_amdgcn_mfma_f32_32x32x16_bf16(b0, qr[8 + d0], p0, 0, 0, 0);
        p1 = __builtin_amdgcn_mfma_f32_32x32x16_bf16(b1, qr[8 + d0], p1, 0, 0, 0); }
}
__device__ __forceinline__ int v_st(int k, int c) { const int kk = (k & ~0xC) | ((k & 4) << 1) | ((k & 8) >> 1); return ((kk >> 3) * 4 + (c >> 5)) * 512 + ((kk & 7) * 32 + (c & 31)) * 2; }
__device__ __forceinline__ int v_rd_base(int lane) { return ((lane & 3) << 3) | (((lane >> 2) & 3) << 6) | (((lane >> 4) & 1) << 5) | (((lane >> 5) & 1) << 8); }
constexpr int v_rd_off(int d0, int ks, int half) { return d0 * 512 + ks * 4096 + half * 2048; }
template <int OFF> __device__ __forceinline__ s16x4 tr_read(int vb) {
    s16x4 r; asm volatile("ds_read_b64_tr_b16 %0, %1 offset:%2" : "=&v"(r) : "v"(vb), "i"(OFF) : "memory"); return r;
}
template <int D0> __device__ __forceinline__ void pv_one(f32x16& od, int vb, bf16x8 pa0, bf16x8 pa1, bf16x8 pa2, bf16x8 pa3) {
    const s16x4 l0 = tr_read<v_rd_off(D0, 0, 0)>(vb), h0 = tr_read<v_rd_off(D0, 0, 1)>(vb), l1 = tr_read<v_rd_off(D0, 1, 0)>(vb), h1 = tr_read<v_rd_off(D0, 1, 1)>(vb);
    const s16x4 l2 = tr_read<v_rd_off(D0, 2, 0)>(vb), h2 = tr_read<v_rd_off(D0, 2, 1)>(vb), l3 = tr_read<v_rd_off(D0, 3, 0)>(vb), h3 = tr_read<v_rd_off(D0, 3, 1)>(vb);
    asm volatile("s_waitcnt lgkmcnt(0)" ::: "memory"); SBAR();
#define PK(L, H) (bf16x8){L[0], L[1], L[2], L[3], H[0], H[1], H[2], H[3]}
    od = __builtin_amdgcn_mfma_f32_32x32x16_bf16(pa0, PK(l0, h0), od, 0, 0, 0);
    od = __builtin_amdgcn_mfma_f32_32x32x16_bf16(pa1, PK(l1, h1), od, 0, 0, 0);
    od = __builtin_amdgcn_mfma_f32_32x32x16_bf16(pa2, PK(l2, h2), od, 0, 0, 0);
    od = __builtin_amdgcn_mfma_f32_32x32x16_bf16(pa3, PK(l3, h3), od, 0, 0, 0);
#undef PK
}
__device__ __forceinline__ void pv_d0(f32x16* o, int vb, bf16x8 pa0, bf16x8 pa1, bf16x8 pa2, bf16x8 pa3) {
    pv_one<0>(o[0], vb, pa0, pa1, pa2, pa3); pv_one<1>(o[1], vb, pa0, pa1, pa2, pa3); pv_one<2>(o[2], vb, pa0, pa1, pa2, pa3); pv_one<3>(o[3], vb, pa0, pa1, pa2, pa3);
}
__device__ __forceinline__ long keyrow(int j, int b) { return j < 4 ? (long)NL + b * CTXL + j * 64 : (long)b * SEQ + (j - 4) * 64; }

__device__ __forceinline__ void attn_unit(const bf16_t* Q, const bf16_t* KV, const bf16_t* KR, bf16_t* O, int b, int h, int qb, char* lds, const int tid) {
    const int wid = tid >> 6, lane = tid & 63, r32 = lane & 31, hi = lane >> 5;
    char* V_lds = lds; char* Kn_lds = lds + 2 * SHM_T; char* Kr_lds = lds + 4 * SHM_T;
    float* wsf = (float*)(lds + 6 * SHM_T) + wid * 64; float* li_l = wsf; float* al_l = wsf + 32;
    float m_reg = -1e30f, l_reg = 0; f32x16 o[4] = {}; bf16x8 qr[12];
    const int tq = qb * 256 + wid * 32 + r32;
    const bf16_t* Qw = Q + ((size_t)b * SEQ + tq) * 3072 + h * 192 + hi * 8;
#pragma unroll
    for (int d0 = 0; d0 < 12; ++d0) qr[d0] = *reinterpret_cast<const bf16x8*>(Qw + d0 * 16);
#pragma unroll
    for (int ax = 0; ax < 2; ++ax) {
        const float pos = (float)(ax ? (tq & 63) : (tq >> 6));
        u32x4 w1 = __builtin_bit_cast(u32x4, qr[8 + 2 * ax]), w2 = __builtin_bit_cast(u32x4, qr[9 + 2 * ax]);
#pragma unroll
        for (int e2 = 0; e2 < 4; ++e2) {
            float o1[2], o2[2];
#pragma unroll
            for (int hh = 0; hh < 2; ++hh) {
                const int i = hi * 8 + e2 * 2 + hh;
                const float ang = pos * exp2f(-(float)i * (13.287712379549449f / 16.0f));
                const float cs = __cosf(ang), sn = __sinf(ang);
                const float x1 = hh ? bf_hi(w1[e2]) : bf_lo(w1[e2]), x2 = hh ? bf_hi(w2[e2]) : bf_lo(w2[e2]);
                o1[hh] = x1 * cs - x2 * sn; o2[hh] = x2 * cs + x1 * sn;
            }
            w1[e2] = cvt_pk_bf16(o1[0], o1[1]); w2[e2] = cvt_pk_bf16(o2[0], o2[1]);
        }
        qr[8 + 2 * ax] = __builtin_bit_cast(bf16x8, w1); qr[9 + 2 * ax] = __builtin_bit_cast(bf16x8, w2);
    }
    const int sr = tid >> 4, sc = (tid & 15) * 8, vst0 = v_st(sr, sc), vst1 = v_st(32 + sr, sc);
    const int krr = tid >> 3, krc = (tid & 7) * 8;
    const int vb0 = (int)(uintptr_t)V_lds + v_rd_base(lane);
    const bf16_t* Kh = KV + h * 256; const bf16_t* Vh = KV + h * 256 + 128;
    bf16x8 sv0, sv1, sk0, sk1, skr;
#define SLOAD(j) do { const long k0_ = keyrow((j), b); sv0 = *reinterpret_cast<const bf16x8*>(Vh + (k0_ + sr) * 4096 + sc); sv1 = *reinterpret_cast<const bf16x8*>(Vh + (k0_ + 32 + sr) * 4096 + sc); \
        sk0 = *reinterpret_cast<const bf16x8*>(Kh + (k0_ + sr) * 4096 + sc); sk1 = *reinterpret_cast<const bf16x8*>(Kh + (k0_ + 32 + sr) * 4096 + sc); \
        skr = *reinterpret_cast<const bf16x8*>(KR + (k0_ + krr) * 64 + krc); } while (0)
#define SWRITE(bi) do { *(bf16x8*)(V_lds + (bi) * SHM_T + vst0) = sv0; *(bf16x8*)(V_lds + (bi) * SHM_T + vst1) = sv1; \
        *(bf16x8*)(Kn_lds + (bi) * SHM_T + KSWZ(sr, sc * 2)) = sk0; *(bf16x8*)(Kn_lds + (bi) * SHM_T + KSWZ(32 + sr, sc * 2)) = sk1; \
        *(bf16x8*)(Kr_lds + (bi) * SHM_T + KSWZ(krr, krc * 2)) = skr; } while (0)
#define RESC(a) do { if (__any((a) < 1.f)) { if (hi == 0) al_l[r32] = (a); asm volatile("s_waitcnt lgkmcnt(0)" ::: "memory"); \
        _Pragma("unroll") for (int d_ = 0; d_ < 4; ++d_) _Pragma("unroll") for (int r_ = 0; r_ < 16; ++r_) o[d_][r_] *= al_l[crow(r_, hi)]; } } while (0)
    constexpr int NT = (CTXL + SEQ) / 64;
    __syncthreads();
    SLOAD(0); SWRITE(0); __syncthreads();
#pragma unroll 1
    for (int j = 0; j < NT; ++j) {
        const int bi = j & 1;
        if (j + 1 < NT) SLOAD(j + 1);
        f32x16 p0, p1; float mn, alpha; bf16x8 pa0, pa1, pa2, pa3;
        qkt(p0, p1, Kn_lds + bi * SHM_T, Kr_lds + bi * SHM_T, qr, r32, hi);
        partialSM(p0, p1, m_reg, mn, alpha);
        finishSM(p0, p1, alpha, l_reg, pa0, pa1, pa2, pa3);
        RESC(alpha);
        SBAR();
        pv_d0(o, vb0 + bi * SHM_T, pa0, pa1, pa2, pa3);
        if (j + 1 < NT) SWRITE(bi ^ 1);
        __syncthreads();
    }
    if (hi == 0) li_l[r32] = l_reg; asm volatile("s_waitcnt lgkmcnt(0)" ::: "memory");
    float rli[16];
#pragma unroll
    for (int r = 0; r < 16; ++r) rli[r] = __builtin_amdgcn_rcpf(li_l[crow(r, hi)]);
    bf16_t* Ow = O + ((size_t)b * SEQ + qb * 256 + wid * 32) * D + h * 128;
#pragma unroll
    for (int r = 0; r < 16; ++r) { const int orow = crow(r, hi);
#pragma unroll
        for (int d0 = 0; d0 < 4; ++d0) { const float val = o[d0][r] * rli[r]; Ow[(size_t)orow * D + d0 * 32 + r32] = (bf16_t)(cvt_pk_bf16(val, val) & 0xffffu); } }
#undef SLOAD
#undef SWRITE
#undef RESC
}
#undef KSWZ
#undef SBAR
}


#define XB_TMO      128
#define XB_XCNT(j)  (256  + 64 * (j))
#define XB_XSUB(j)  (1280 + 64 * (j))
#define XB_XGEN(j)  (2304 + 64 * (j))
#define XB_TOP      3328
#define XB_TOPGEN   3392
#define XCD_BAR_WORDS 3456
#define XB_SPIN_CAP (1u << 22)
__device__ __forceinline__ unsigned xb_ld(unsigned* p)              { return __hip_atomic_load(p, __ATOMIC_RELAXED, __HIP_MEMORY_SCOPE_AGENT); }
__device__ __forceinline__ unsigned xb_add(unsigned* p, unsigned v) { return __hip_atomic_fetch_add(p, v, __ATOMIC_RELAXED, __HIP_MEMORY_SCOPE_AGENT); }
__device__ __forceinline__ unsigned xb_xcc_id() { return (unsigned)__builtin_amdgcn_s_getreg((3 << 11) | 20) & 0xFu; }
#define XB_SPIN(cond, bar) do { unsigned _sp = 0; while (cond) { __builtin_amdgcn_s_sleep(1); \
    if ((++_sp & 255u) == 0u) { if (xb_ld(&(bar)[XB_TMO])) break; if (_sp > XB_SPIN_CAP) { atomicAdd(&(bar)[XB_TMO], 1u); break; } } } } while (0)
struct XcdBarrier { unsigned* bar; unsigned x; volatile LAS unsigned* st; };
__device__ __forceinline__ void xcd_barrier_complete(unsigned* bar, unsigned x, unsigned& nloc, unsigned& nx) {
    const unsigned G = gridDim.x * gridDim.y * gridDim.z;
    unsigned sum, cnt, mine, sp = 0u;
    for (;;) {
        sum = 0u; cnt = 0u; mine = 0u;
#pragma unroll
        for (unsigned j = 0; j < 16; ++j) { const unsigned c = xb_ld(&bar[XB_XCNT(j)]); sum += c; cnt += (c > 0u) ? 1u : 0u; mine = (j == x) ? c : mine; }
        if (sum == G) break;
        __builtin_amdgcn_s_sleep(1);
        if ((++sp & 255u) == 0u) { if (xb_ld(&bar[XB_TMO])) break; if (sp > XB_SPIN_CAP) { atomicAdd(&bar[XB_TMO], 1u); break; } }
    }
    nloc = mine > 0u ? mine : 1u; nx = cnt > 0u ? cnt : 1u;
}
__device__ __forceinline__ void xcd_barrier(const XcdBarrier& b) {
    asm volatile("s_waitcnt vmcnt(0)" ::: "memory");
    __syncthreads();
    if (threadIdx.x == 0) {
        unsigned* bar = b.bar;
        __builtin_amdgcn_s_waitcnt(0);
        unsigned nloc = b.st[0], nx = b.st[1];
        if (nloc == 0u) { xcd_barrier_complete(bar, b.x, nloc, nx); b.st[0] = nloc; b.st[1] = nx; }
        const unsigned old = xb_add(&bar[XB_XSUB(b.x)], 1u);
        const unsigned gen = old / nloc;
        if (old + 1u == (gen + 1u) * nloc) {
            __builtin_amdgcn_fence(__ATOMIC_RELEASE, "agent");
            asm volatile("s_waitcnt vmcnt(0)" ::: "memory");
            const unsigned og = xb_add(&bar[XB_TOP], 1u);
            const unsigned tg = og / nx;
            if (og + 1u == (tg + 1u) * nx) xb_add(&bar[XB_TOPGEN], 1u);
            else XB_SPIN(xb_ld(&bar[XB_TOPGEN]) == tg, bar);
            __builtin_amdgcn_fence(__ATOMIC_ACQUIRE, "agent");
            xb_add(&bar[XB_XGEN(b.x)], 1u);
            asm volatile("s_waitcnt vmcnt(0)" ::: "memory");
        } else {
            XB_SPIN(xb_ld(&bar[XB_XGEN(b.x)]) == gen, bar);
            __builtin_amdgcn_fence(__ATOMIC_ACQUIRE, "agent");
            asm volatile("s_waitcnt vmcnt(0)" ::: "memory");
        }
    }
    __syncthreads();
}

__device__ __forceinline__ void setup_gemm(const KP& P, int ph, int gi, pg8::Gemm& g, pg8::Epi& e) {
    unsigned char* ws = P.ws(); const bf16_t* W = (const bf16_t*)(ws + WS_W); bf16_t* BIG = (bf16_t*)(ws + WS_BIG);
    const float* MOD = (const float*)(ws + WS_MOD);
    e.mode = 0; e.perm = 1; e.acts = 0; e.o0 = nullptr; e.o1 = nullptr; e.o2 = nullptr; e.sCz = 0; e.ldc = D; e.b0 = nullptr; e.b1 = nullptr;
    g.sAz = 0; g.sBz = 0; g.nz = 1; g.M = T;
    const size_t TD = (size_t)T * D;
    switch (ph) {
    case 2:
        if (gi == 0) {
            g.A = BIG; g.lda = D; g.sAz = (int)TD; g.Bt = W + W_RKV / 2; g.ldb = D; g.sBz = D * D; g.N = D; g.K = D; g.nz = 3;
            e.o0 = P.out(); e.o1 = ws + WS_KV; e.o2 = ws + WS_KV + S68; e.ldc = D;
        } else {
            g.A = BIG + 3 * TD; g.lda = D; g.sAz = (int)TD; g.Bt = W + W_L1 / 2; g.ldb = D; g.sBz = 256 * D; g.N = 256; g.K = D; g.nz = 3;
            e.o0 = (unsigned char*)P.out() + S68; e.sCz = (long)T * 256; e.ldc = 256; e.acts = 1 | (0 << 4) | (2 << 8);
        }
        break;
    case 3:
        g.A = (const bf16_t*)((unsigned char*)P.out() + S68) + (size_t)gi * T * 256; g.lda = 256; g.sAz = 64; g.Bt = W + W_L2 / 2 + (size_t)gi * 2 * D * 256; g.ldb = 256; g.sBz = D * 256 + 64; g.N = D; g.K = 128; g.nz = 2;
        e.mode = 1; e.acts = 2 * gi; e.o0 = BIG + (size_t)gi * 2 * TD; e.sCz = (long)TD; e.ldc = D; e.b0 = P.in(13); e.b1 = P.in(16);
        break;
    case 5:
        g.A = (const bf16_t*)((unsigned char*)P.out() + S68) + 2 * (size_t)T * 256; g.lda = 256; g.Bt = W + W_G2 / 2; g.ldb = 256; g.N = D; g.K = 256;
        e.o0 = BIG; e.ldc = D;
        break;
    case 7:
        g.A = BIG + TD; g.lda = D; g.Bt = W + W_RWO / 2; g.ldb = D; g.N = D; g.K = D;
        e.mode = 3; e.perm = 0; e.xin_l = P.in(0); e.xin_c = P.in(2); e.xout_l = P.out(); e.xout_c = (float*)(ws + WS_XC); e.gate = MOD + 4096;
        break;
    case 9:
        g.A = (const bf16_t*)(ws + WS_KV); g.lda = D; g.Bt = W + W_UP / 2; g.ldb = D; g.N = 2 * DFF; g.K = D;
        e.mode = 4; e.o0 = ws + WS_GF; e.o1 = ws + WS_BIG; e.o2 = ws + WS_BIG + 16 * MiB; e.b0 = P.in(33); e.b1 = P.in(34);
        break;
    case 11:
        g.A = (const bf16_t*)(ws + WS_GF); g.lda = DFF; g.Bt = W + W_DN / 2; g.ldb = DFF; g.N = D; g.K = DFF;
        e.mode = 3; e.perm = 0; e.xin_l = P.out(); e.xin_c = (const float*)(ws + WS_XC); e.xout_l = P.out(); e.xout_c = (float*)(ws + WS_XC); e.gate = MOD + 10240;
        break;
    case 13:
        g.A = BIG; g.lda = D; g.Bt = W + W_MLD / 2; g.ldb = D; g.N = 1280; g.K = D;
        e.mode = 2; e.perm = 0; e.o0 = ws + WS_BIG + S68; e.ldc = 1280;
        break;
    case 15:
        if (gi == 0) {
            g.A = (const bf16_t*)(ws + WS_BIG + 153 * MiB); g.lda = 512; g.Bt = W + W_UQ / 2; g.ldb = 512; g.M = NL; g.N = 3072; g.K = 512;
            e.o0 = ws + WS_BIG + 190 * MiB; e.ldc = 3072;
        } else {
            g.A = (const bf16_t*)(ws + WS_BIG + 170 * MiB); g.lda = 512; g.Bt = W + W_UKV / 2; g.ldb = 512; g.N = 4096; g.K = 512;
            e.o0 = ws + WS_KV; e.ldc = 4096;
        }
        break;
    case 17:
        g.A = BIG; g.lda = D; g.Bt = W + W_MLO / 2; g.ldb = D; g.M = NL; g.N = D; g.K = D;
        e.mode = 3; e.perm = 0; e.xin_l = P.out(); e.xin_c = (const float*)(ws + WS_XC); e.xout_l = P.out(); e.xout_c = (float*)(ws + WS_XC); e.gate = MOD + 5 * MODW + 4096;
        break;
    case 19:
        g.A = (const bf16_t*)(ws + WS_KV); g.lda = D; g.Bt = W + W_UP / 2; g.ldb = D; g.M = NL; g.N = 2 * DFF; g.K = D;
        e.mode = 4; e.o0 = ws + WS_GF; e.o1 = ws + WS_BIG; e.o2 = ws + WS_BIG + 16 * MiB; e.b0 = P.in(33) + 3 * DFF; e.b1 = P.in(34) + DFF;
        break;
    default:
        g.A = (const bf16_t*)(ws + WS_GF); g.lda = DFF; g.Bt = W + W_DN / 2; g.ldb = DFF; g.M = NL; g.N = D; g.K = DFF;
        e.mode = 3; e.perm = 0; e.xin_l = P.out(); e.xin_c = (const float*)(ws + WS_XC); e.xout_l = P.out(); e.xout_c = (float*)(ws + WS_XC); e.gate = MOD + 5 * MODW + 10240;
        break;
    }
}

namespace pg8 { __device__ __forceinline__ void make_epi(const EpiSrc& es, Epi& E) { const KP P = kargs(); Gemm g; setup_gemm(P, es.ph, es.gi, g, E); } }
__global__ void __launch_bounds__(512) fwd_megakernel(Params Punused) {
    extern __shared__ __attribute__((aligned(16))) unsigned char lds_raw[];
    cg::grid_group grid = cg::this_grid();
    LAS unsigned char* lds = (LAS unsigned char*)lds_raw;
    volatile LAS unsigned* bst = (volatile LAS unsigned*)(lds + 131072 + 64);
    if (threadIdx.x < 2) bst[threadIdx.x] = 0u;
    __syncthreads();
    if (blockIdx.x == 0) { const KP P0 = kargs(); unsigned* bw = (unsigned*)(P0.ws() + WS_BAR); for (int i = threadIdx.x; i < XCD_BAR_WORDS; i += 512) __hip_atomic_store(bw + i, 0u, __ATOMIC_RELAXED, __HIP_MEMORY_SCOPE_AGENT); }
#ifndef EN_MASK
#define EN_MASK 0xffffffffu
#endif
#define EN(k) (((EN_MASK) >> (k)) & 1u)
#ifndef DUP_MASK
#define DUP_MASK 0u
#endif
#ifndef XSYNC
#define XSYNC 0
#endif
#pragma unroll 1
    for (int ph2 = 0; ph2 < 46; ++ph2) {
        const int ph = ph2 >> 1;
        if ((ph2 & 1) && !(((unsigned)(DUP_MASK) >> ph) & 1u)) continue;
        int tid = threadIdx.x; asm volatile("" : "+v"(tid));
        int bx = blockIdx.x, G = gridDim.x; asm volatile("" : "+s"(bx), "+s"(G));
#define lane (tid & 63)
#define wave (__builtin_amdgcn_readfirstlane(tid >> 6))
#define gw (bx * 8 + wave)
#define ngw (G * 8)
#define gtid (bx * 512 + tid)
#define ngt (G * 512)
        const KP P = kargs();
        unsigned char* ws = P.ws();
        bf16_t* W = (bf16_t*)(ws + WS_W);
        const float* MOD = (const float*)(ws + WS_MOD);
        switch (ph) {
        case 0: if (EN(0)) {
            adaln_tasks(P, lds, tid, bx, G);
            __syncthreads();
            LAS float* scr = (LAS float*)(lds + wave * 16384);
            constexpr int NIT = 4 * 2048 + 4 * 96 + 256 + 256 + 11264 + 5632;
            for (int it = gw; it < NIT; it += ngw) {
                int r = it;
                TR(P.in(9), D, D, W + W_RKV / 2, D, 0)
                TR(P.in(10), D, D, W + W_RKV / 2 + (size_t)D * D, D, 0)
                TR(P.in(11), D, D, W + W_RKV / 2 + 2 * (size_t)D * D, D, 0)
                TR(P.in(12), D, D, W + W_RWO / 2, D, 0)
                TR(P.in(14), D, 96, W + W_L1 / 2, D, 0)
                TR(P.in(14) + D * 96, D, 96, W + W_L1 / 2, D, 96)
                TR(P.in(17), D, 96, W + W_L1 / 2 + 256 * D, D, 0)
                TR(P.in(17) + D * 96, D, 96, W + W_L1 / 2 + 256 * D, D, 96)
                TR(P.in(19), D, 256, W + W_L1 / 2 + 2 * 256 * D, D, 0)
                TR(P.in(20), 256, D, W + W_G2 / 2, 256, 0)
                TRI(P.in(32), D, 2 * DFF, W + W_UP / 2, D)
                TR(P.in(35), DFF, D, W + W_DN / 2, DFF, 0)
            }
            for (int idx = gtid; idx < 4 * D * 256; idx += ngt) {
                const int z = idx >> 19, n = (idx >> 8) & 2047, kk = idx & 255, d = z & 1;
                const float* src = z < 2 ? P.in(15) : P.in(18);
                float val = 0.f; if (kk >= 96 * d && kk < 96 * d + 96) val = src[((size_t)d * 96 + (kk - 96 * d)) * D + n];
                W[W_L2 / 2 + idx] = (bf16_t)(cvt_pk_bf16(val, val) & 0xffffu);
            }
            for (int idx = gtid; idx < 2 * 64 * D; idx += ngt) { const int z = idx / (64 * D), rem = idx % (64 * D); W[W_L1 / 2 + (size_t)z * 256 * D + 192 * D + rem] = 0; }
        } break;
        case 1: if (EN(1)) mix_phase(P, gw, ngw, lane); break;
        case 4: if (EN(4)) scan_phase(P, lds, tid, bx, G); break;
        case 6: if (EN(6)) readout_phase(P, gw, ngw, lane); break;
        case 8: if (EN(8)) modnorm_phase(P.out(), (const float*)(ws + WS_XC), P.in(6) + D, MOD, 6144, 8192, (bf16_t*)(ws + WS_KV), T, gw, ngw, lane); break;
        case 10: if (EN(10)) fixup_phase((const bf16_t*)(ws + WS_BIG), (const bf16_t*)(ws + WS_BIG + 16 * MiB), (bf16_t*)(ws + WS_GF), P.in(33), P.in(34), T, gtid, ngt); break;
        case 12: if (EN(12)) {
            modnorm_phase(P.out(), (const float*)(ws + WS_XC), P.in(6) + 2 * D, MOD + 5 * MODW, 0, 2048, (bf16_t*)(ws + WS_BIG), T, gw, ngw, lane);
            LAS float* scr = (LAS float*)(lds + wave * 16384);
            constexpr int NIT = 32 * 34 + 8 * 96 + 8 * 128 + 2048 + 11264 + 5632;
            for (int it = gw; it < NIT; it += ngw) {
                int r = it;
                TR(P.in(26), D, 1088, W + W_MLD / 2, D, 0)
                TR(P.in(29), 512, 3072, W + W_UQ / 2, 512, 0)
                TR(P.in(30), 512, 4096, W + W_UKV / 2, 512, 0)
                TR(P.in(31), D, D, W + W_MLO / 2, D, 0)
                TRI(P.in(32) + (size_t)D * 2 * DFF, D, 2 * DFF, W + W_UP / 2, D)
                TR(P.in(35) + (size_t)DFF * D, DFF, D, W + W_DN / 2, DFF, 0)
            }
            for (int idx = gtid; idx < 192 * D; idx += ngt) W[W_MLD / 2 + (size_t)1088 * D + idx] = 0;
        } break;
        case 14: if (EN(14)) mla_mid_phase(P, gw, ngw, lane); break;
        case 16: if (EN(16)) {
            const int vcu = (G % 8 == 0) ? (bx % 8) * (G / 8) + bx / 8 : bx;
            for (int u = vcu; u < 1024; u += G) {
                const int bh = u >> 4, qb = u & 15;
                att::attn_unit((const bf16_t*)(ws + WS_BIG + 190 * MiB), (const bf16_t*)(ws + WS_KV), (const bf16_t*)(ws + WS_BIG + 187 * MiB), (bf16_t*)(ws + WS_BIG), bh >> 4, bh & 15, qb, (char*)lds_raw, tid);
            }
        } break;
        case 18: if (EN(18)) modnorm_phase(P.out(), (const float*)(ws + WS_XC), P.in(6) + 3 * D, MOD + 5 * MODW, 6144, 8192, (bf16_t*)(ws + WS_KV), NL, gw, ngw, lane); break;
        case 20: if (EN(20)) fixup_phase((const bf16_t*)(ws + WS_BIG), (const bf16_t*)(ws + WS_BIG + 16 * MiB), (bf16_t*)(ws + WS_GF), P.in(33) + 3 * DFF, P.in(34) + DFF, NL, gtid, ngt); break;
        case 22: if (EN(22)) {
            const float* fg = P.in(7);
            for (int r0 = 4 * gw; r0 < NL; r0 += 4 * ngw) {
                float* xr = P.out() + (size_t)r0 * D;
                f32x4 x[4][8]; float ss[4];
#pragma unroll
                for (int i = 0; i < 4; ++i) {
                    float sq = 0.f;
#pragma unroll
                    for (int j = 0; j < 8; ++j) { x[i][j] = *(const f32x4*)(xr + (size_t)i * D + 4 * lane + 256 * j); sq += (x[i][j].x * x[i][j].x + x[i][j].y * x[i][j].y) + (x[i][j].z * x[i][j].z + x[i][j].w * x[i][j].w); }
                    ss[i] = sq;
                }
#pragma unroll
                for (int o = 1; o < 64; o <<= 1) {
#pragma unroll
                    for (int i = 0; i < 4; ++i) ss[i] += __shfl_xor(ss[i], o);
                }
#pragma unroll
                for (int j = 0; j < 8; ++j) {
                    const int col = 4 * lane + 256 * j; const f32x4 gg = *(const f32x4*)(fg + col);
#pragma unroll
                    for (int i = 0; i < 4; ++i) *(f32x4*)(xr + (size_t)i * D + col) = x[i][j] * rsqrtf(ss[i] * (1.0f / D) + 1e-6f) * gg;
                }
            }
        } break;
        default: if (EN(2)) {
            const int ng = (ph == 2 || ph == 3 || ph == 15) ? 2 : 1;
#pragma unroll 1
            for (int gi = 0; gi < ng; ++gi) {
                pg8::Gemm g; pg8::Epi e; setup_gemm(P, ph, gi, g, e);
                pg8::StaticOrder S; S.init(g.M, g.N, g.nz, G, (ph == 3 && gi == 1) ? (bx + 64) % G : bx);
                pg8::EpiSrc es; es.ph = ph; es.gi = gi;
                pg8::gemm_phase(lds, g, S, es, e.perm | (e.mode == 4 ? 2 : 0), tid);
            }
        } break;
        }
        if (ph == 0) {
            grid.sync();
            if (threadIdx.x == 0) { const KP P1 = kargs(); (void)xb_add((unsigned*)(P1.ws() + WS_BAR) + XB_XCNT(xb_xcc_id()), 1u); }
        } else { XcdBarrier xb2; { const KP P1 = kargs(); xb2.bar = (unsigned*)(P1.ws() + WS_BAR); } xb2.x = xb_xcc_id(); xb2.st = (volatile LAS unsigned*)(lds + 131072 + 64); xcd_barrier(xb2); }
    }
}

#undef lane
#undef wave
#undef gw
#undef ngw
#undef gtid
#undef ngt
extern "C" void kernel_launch(void* const* d_in, const int* in_sizes, int n_in, void* d_out, int out_size, void* d_ws, size_t ws_size, hipStream_t stream) {
    static int grid = 0;
    if (grid == 0) {
        if (n_in != 36 || out_size != NL * D || ws_size < WS_END) { fprintf(stderr, "kernel_launch: unexpected shapes (n_in %d out %d ws %zu)\n", n_in, out_size, ws_size); grid = -1; return; }
        int dev = 0, cus = 0, per_cu = 0;
        hipGetDevice(&dev);
        hipDeviceGetAttribute(&cus, hipDeviceAttributeMultiprocessorCount, dev);
        hipFuncSetAttribute((const void*)fwd_megakernel, hipFuncAttributeMaxDynamicSharedMemorySize, LDS_BYTES);
        hipOccupancyMaxActiveBlocksPerMultiprocessor(&per_cu, (const void*)fwd_megakernel, 512, LDS_BYTES);
        if (per_cu < 1) per_cu = 1;
        grid = cus * per_cu;
        if (grid > 256) grid = 256;
    }
    if (grid < 0) return;
    Params p{};
    for (int i = 0; i < 36; ++i) p.in[i] = (const float*)d_in[i];
    p.out = (float*)d_out; p.ws = (unsigned char*)d_ws;
    void* args[] = {&p};
    hipError_t e = hipLaunchCooperativeKernel((const void*)fwd_megakernel, dim3(grid), dim3(512), args, LDS_BYTES, stream);
    if (e != hipSuccess) fprintf(stderr, "cooperative launch failed: %s (grid %d)\n", hipGetErrorString(e), grid);
}
```
